# Optimizing an MI355X kernel written in HIP

```python
import math
import jax, jax.numpy as jnp
from jax import lax
import numpy as np

D_MODEL = 1024
BATCH = 8
SEQ = 4096
DEPTH = 1

D_SSM = D_MODEL // 2
SSM_GROUP = 16
N_SSM_GROUPS = D_SSM // SSM_GROUP
SSM_STATE = 64
SSM_DT_MIN = 1e-3
SSM_DT_MAX = 1e-1
D_ATTN = D_MODEL // 2
DIFF_HEAD_DIM = 64
N_DIFF_HEADS = D_ATTN // (2 * DIFF_HEAD_DIM)
ROPE_THETA = 10000.0
Q_BLOCK = 128
N_BRANCHES = 2
D_IN = D_SSM + 3 * D_ATTN + N_BRANCHES * D_MODEL
D_FF = -(-8 * D_MODEL // (3 * 256)) * 256
DEEPNORM_ALPHA = (2.0 * DEPTH) ** 0.25
DEEPNORM_BETA = (8.0 * DEPTH) ** -0.25
LN_EPS = 1e-5
RMS_EPS = 1e-5

kernel_name = "hybrid_s5_diffattn_gated_deepnorm"


def lambda_init_for(layer_idx):
    return 0.8 - 0.6 * math.exp(-0.3 * layer_idx)


def layer_norm(x, g, b):
    xf = x.astype(jnp.float32)
    mu = jnp.mean(xf, axis=-1, keepdims=True)
    xc = xf - mu
    var = jnp.mean(xc * xc, axis=-1, keepdims=True)
    y = xc * lax.rsqrt(var + LN_EPS) * g.astype(jnp.float32) + b.astype(jnp.float32)
    return y.astype(x.dtype)


def rope_tables(seq_len, dim):
    inv_freq = ROPE_THETA ** (-jnp.arange(0, dim, 2, dtype=jnp.float32) / dim)
    ang = jnp.arange(seq_len, dtype=jnp.float32)[:, None] * inv_freq[None, :]
    return jnp.cos(ang), jnp.sin(ang)


def apply_rope(t, cos, sin):
    half = t.shape[-1] // 2
    t1, t2 = t[..., :half], t[..., half:]
    c = cos[None, :, None, None, :]
    s = sin[None, :, None, None, :]
    return jnp.concatenate([t1 * c - t2 * s, t2 * c + t1 * s], axis=-1)


def s5_branch(u, lam_re, lam_im, log_step, b_re, b_im, c_re, c_im, d_skip, w_glu):
    bsz, seq = u.shape[0], u.shape[1]
    f32 = jnp.float32
    uf = u.astype(f32).reshape(bsz, seq, N_SSM_GROUPS, SSM_GROUP)
    lr, li = lam_re.astype(f32), lam_im.astype(f32)
    dt = jnp.exp(log_step.astype(f32))[:, None]
    mag = jnp.exp(lr * dt)
    abar_re, abar_im = mag * jnp.cos(li * dt), mag * jnp.sin(li * dt)
    nr, ni = abar_re - 1.0, abar_im
    den = lr * lr + li * li
    fr = (nr * lr + ni * li) / den
    fi = (ni * lr - nr * li) / den
    br, bi = b_re.astype(f32), b_im.astype(f32)
    bb_re = fr[..., None] * br - fi[..., None] * bi
    bb_im = fr[..., None] * bi + fi[..., None] * br
    bu_re = jnp.einsum('bsgh,gph->bsgp', uf, bb_re)
    bu_im = jnp.einsum('bsgh,gph->bsgp', uf, bb_im)
    a_re = jnp.broadcast_to(abar_re, bu_re.shape)
    a_im = jnp.broadcast_to(abar_im, bu_im.shape)

    def combine(e1, e2):
        a1r, a1i, b1r, b1i = e1
        a2r, a2i, b2r, b2i = e2
        return (a2r * a1r - a2i * a1i,
                a2r * a1i + a2i * a1r,
                a2r * b1r - a2i * b1i + b2r,
                a2r * b1i + a2i * b1r + b2i)

    _, _, s_re, s_im = lax.associative_scan(combine, (a_re, a_im, bu_re, bu_im), axis=1)
    y = (jnp.einsum('bsgp,ghp->bsgh', s_re, c_re.astype(f32))
         - jnp.einsum('bsgp,ghp->bsgh', s_im, c_im.astype(f32))
         + d_skip.astype(f32) * uf)
    y = jax.nn.gelu(y.reshape(bsz, seq, D_SSM))
    ga = jnp.einsum('bse,ef->bsf', y, w_glu.astype(f32))
    a, g = ga[..., :D_SSM], ga[..., D_SSM:]
    return (a * jax.nn.sigmoid(g)).astype(u.dtype)


def diff_attention(q, k, v, lq1, lk1, lq2, lk2, subln_gain, lambda_init):
    bsz, seq = q.shape[0], q.shape[1]
    f32 = jnp.float32
    qf = q.astype(f32).reshape(bsz, seq, N_DIFF_HEADS, 2, DIFF_HEAD_DIM)
    kf = k.astype(f32).reshape(bsz, seq, N_DIFF_HEADS, 2, DIFF_HEAD_DIM)
    vf = v.astype(f32).reshape(bsz, seq, N_DIFF_HEADS, 2 * DIFF_HEAD_DIM)
    cos, sin = rope_tables(seq, DIFF_HEAD_DIM)
    qf = apply_rope(qf, cos, sin) * (DIFF_HEAD_DIM ** -0.5)
    kf = apply_rope(kf, cos, sin)
    lam = (jnp.exp(jnp.sum(lq1.astype(f32) * lk1.astype(f32)))
           - jnp.exp(jnp.sum(lq2.astype(f32) * lk2.astype(f32))) + lambda_init)
    outs = []
    for i in range(seq // Q_BLOCK):
        q0 = i * Q_BLOCK
        kl = q0 + Q_BLOCK
        qb = qf[:, q0:kl]
        kb = kf[:, :kl]
        vb = vf[:, :kl]
        s = jnp.einsum('bqhcd,bkhcd->bhcqk', qb, kb)
        mask = jnp.arange(kl)[None, :] <= (q0 + jnp.arange(Q_BLOCK))[:, None]
        s = jnp.where(mask, s, -jnp.inf)
        p = jax.nn.softmax(s, axis=-1)
        w = p[:, :, 0] - lam * p[:, :, 1]
        outs.append(jnp.einsum('bhqk,bkhe->bqhe', w, vb))
    o = jnp.concatenate(outs, axis=1)
    ms = jnp.mean(o * o, axis=-1, keepdims=True)
    o = o * lax.rsqrt(ms + RMS_EPS) * subln_gain.astype(f32) * (1.0 - lambda_init)
    return o.reshape(bsz, seq, D_ATTN).astype(q.dtype)


def setup_inputs(seed: int = 0) -> dict:
    key = jax.random.key(seed)
    ks = jax.random.split(key, 32)
    L, D, f32 = DEPTH, D_MODEL, jnp.float32
    G, P, H = N_SSM_GROUPS, SSM_STATE, SSM_GROUP
    nrm = lambda k, shape: jax.random.normal(k, shape, f32)
    x = nrm(ks[0], (BATCH, SEQ, D))
    w_in = nrm(ks[1], (L, D, D_IN)) * D ** -0.5
    b_gate = nrm(ks[2], (L, N_BRANCHES * D)) * 0.01
    ssm_lambda_re = -0.5 + 0.005 * nrm(ks[3], (L, G, P))
    ssm_lambda_im = (math.pi * jnp.arange(P, dtype=f32))[None, None, :] + 0.01 * nrm(ks[4], (L, G, P))
    ssm_log_step = jax.random.uniform(ks[5], (L, G), f32, math.log(SSM_DT_MIN), math.log(SSM_DT_MAX))
    ssm_b_re = nrm(ks[6], (L, G, P, H)) * (2 * H) ** -0.5
    ssm_b_im = nrm(ks[7], (L, G, P, H)) * (2 * H) ** -0.5
    ssm_c_re = nrm(ks[8], (L, G, H, P)) * (2 * P) ** -0.5
    ssm_c_im = nrm(ks[9], (L, G, H, P)) * (2 * P) ** -0.5
    ssm_d = nrm(ks[10], (L, G, H))
    w_glu = nrm(ks[11], (L, D_SSM, 2 * D_SSM)) * D_SSM ** -0.5
    lambda_q1 = nrm(ks[12], (L, DIFF_HEAD_DIM)) * 0.1
    lambda_k1 = nrm(ks[13], (L, DIFF_HEAD_DIM)) * 0.1
    lambda_q2 = nrm(ks[14], (L, DIFF_HEAD_DIM)) * 0.1
    lambda_k2 = nrm(ks[15], (L, DIFF_HEAD_DIM)) * 0.1
    subln_gain = 1.0 + 0.01 * nrm(ks[16], (L, 2 * DIFF_HEAD_DIM))
    w_proj_ssm = nrm(ks[17], (L, D_SSM, D)) * D_SSM ** -0.5
    w_proj_attn = nrm(ks[18], (L, D_ATTN, D)) * D_ATTN ** -0.5
    w_out = nrm(ks[19], (L, D, D)) * D ** -0.5 * DEEPNORM_BETA
    ln1_g = 1.0 + 0.01 * nrm(ks[20], (L, D))
    ln1_b = 0.01 * nrm(ks[21], (L, D))
    w_ffn_gate = nrm(ks[22], (L, D, D_FF)) * D ** -0.5
    w_ffn_up = nrm(ks[23], (L, D, D_FF)) * D ** -0.5
    w_ffn_down = nrm(ks[24], (L, D_FF, D)) * D_FF ** -0.5 * DEEPNORM_BETA
    ln2_g = 1.0 + 0.01 * nrm(ks[25], (L, D))
    ln2_b = 0.01 * nrm(ks[26], (L, D))
    return {"x": x, "w_in": w_in, "b_gate": b_gate,
            "ssm_lambda_re": ssm_lambda_re, "ssm_lambda_im": ssm_lambda_im,
            "ssm_log_step": ssm_log_step, "ssm_b_re": ssm_b_re, "ssm_b_im": ssm_b_im,
            "ssm_c_re": ssm_c_re, "ssm_c_im": ssm_c_im, "ssm_d": ssm_d, "w_glu": w_glu,
            "lambda_q1": lambda_q1, "lambda_k1": lambda_k1, "lambda_q2": lambda_q2,
            "lambda_k2": lambda_k2, "subln_gain": subln_gain,
            "w_proj_ssm": w_proj_ssm, "w_proj_attn": w_proj_attn, "w_out": w_out,
            "ln1_g": ln1_g, "ln1_b": ln1_b,
            "w_ffn_gate": w_ffn_gate, "w_ffn_up": w_ffn_up, "w_ffn_down": w_ffn_down,
            "ln2_g": ln2_g, "ln2_b": ln2_b}


def reference(x, w_in, b_gate, ssm_lambda_re, ssm_lambda_im, ssm_log_step, ssm_b_re, ssm_b_im,
              ssm_c_re, ssm_c_im, ssm_d, w_glu, lambda_q1, lambda_k1, lambda_q2, lambda_k2,
              subln_gain, w_proj_ssm, w_proj_attn, w_out, ln1_g, ln1_b,
              w_ffn_gate, w_ffn_up, w_ffn_down, ln2_g, ln2_b):
    bsz, seq = x.shape[0], x.shape[1]
    o_q = D_SSM
    o_k = o_q + D_ATTN
    o_v = o_k + D_ATTN
    o_g = o_v + D_ATTN
    for l in range(DEPTH):
        lambda_init = lambda_init_for(l)
        h = jnp.einsum('bsd,de->bse', x, w_in[l])
        u = h[..., :o_q]
        q = h[..., o_q:o_k]
        k = h[..., o_k:o_v]
        v = h[..., o_v:o_g]
        gates = jax.nn.sigmoid((h[..., o_g:] + b_gate[l]).astype(jnp.float32))
        gates = gates.reshape(bsz, seq, N_BRANCHES, D_MODEL)
        y_ssm = s5_branch(u, ssm_lambda_re[l], ssm_lambda_im[l], ssm_log_step[l],
                          ssm_b_re[l], ssm_b_im[l], ssm_c_re[l], ssm_c_im[l], ssm_d[l], w_glu[l])
        y_att = diff_attention(q, k, v, lambda_q1[l], lambda_k1[l], lambda_q2[l], lambda_k2[l],
                               subln_gain[l], lambda_init)
        p_ssm = jnp.einsum('bse,ed->bsd', y_ssm, w_proj_ssm[l]).astype(jnp.float32)
        p_att = jnp.einsum('bse,ed->bsd', y_att, w_proj_attn[l]).astype(jnp.float32)
        merged = (gates[:, :, 0] * p_ssm + gates[:, :, 1] * p_att).astype(x.dtype)
        mix = jnp.einsum('bsd,de->bse', merged, w_out[l])
        x = layer_norm(DEEPNORM_ALPHA * x + mix, ln1_g[l], ln1_b[l])
        a = jnp.einsum('bsd,df->bsf', x, w_ffn_gate[l])
        b = jnp.einsum('bsd,df->bsf', x, w_ffn_up[l])
        ff = jnp.einsum('bsf,fd->bsd', jax.nn.silu(a) * b, w_ffn_down[l])
        x = layer_norm(DEEPNORM_ALPHA * x + ff, ln2_g[l], ln2_b[l])
    return x
```

```cpp
#include <hip/hip_runtime.h>
#include <hip/hip_cooperative_groups.h>
#include <cstdio>
#include <cstdint>
#include <cmath>
namespace cg = cooperative_groups;


#ifndef MK_N_LAUNCHES
#define MK_N_LAUNCHES 13
#endif

namespace pg8 {
#define PG8_LAS __attribute__((address_space(3)))
typedef unsigned short bf16_t;
typedef short bf16x8 __attribute__((ext_vector_type(8)));
typedef float f32x4 __attribute__((ext_vector_type(4)));
typedef float f32x2 __attribute__((ext_vector_type(2)));
typedef unsigned u32x4 __attribute__((ext_vector_type(4)));
constexpr int BM = 256, BK = 64, HALF = 128, HTB = HALF * BK * 2  , STAGE_BYTES = 8 * HTB, NXCD = 8, WGM = 8;

__host__ __device__ __forceinline__ int lds_byte(int r, int c) { const int st = (r >> 4) * 2 + (c >> 5), rr = r & 15, cc = c & 31, ob = rr * 64 + cc * 2; return st * 1024 + (ob ^ (((ob >> 9) & 1) << 5)); }
__host__ __device__ __forceinline__ void stage_rc(int b, int& R, int& C) { const int st = b / 1024, sb = b % 1024, swz = sb ^ (((sb >> 9) & 1) << 5); R = (st >> 1) * 16 + swz / 64; C = (st & 1) * 32 + (swz % 64) / 2; }
__host__ __device__ __forceinline__ int perm32(int rho) { const int n = rho >> 4, i = rho & 15; return 8 * (i >> 2) + 4 * n + (i & 3); }

struct Unit { const char* a; const char* b; int pm, pn, kind, keep; };
struct Gemm { int lda, ldb, K; };

struct TileOrder {
    int nM, nN, nwg, G, c, chain, grouped; const char* A; const char* B; size_t a_t, b_t, a_k, b_k;
    __device__ __forceinline__ bool next(int i, Unit& u) const {
        const int ti = (chain == 2) ? (i >> 1) : i, kind = (chain == 2) ? (i & 1) : 0;
        const long L = (long)ti * G + c; if (L >= nwg) return false;
        int wgid = (int)L; { const int q = nwg / NXCD, r = nwg % NXCD, xcd = wgid % NXCD, off = wgid / NXCD; wgid = (xcd < r ? xcd * (q + 1) : r * (q + 1) + (xcd - r) * q) + off; }
        const int nig = WGM * nN, gid = wgid / nig, fm = gid * WGM, gsz = (nM - fm) < WGM ? (nM - fm) : WGM;
        u.pm = fm + ((wgid % nig) % gsz); u.pn = (wgid % nig) / gsz;
        u.a = A + (size_t)u.pm * a_t + (size_t)kind * a_k;
        u.b = B + (size_t)(grouped ? (u.pm >> 3) : u.pn) * b_t + (size_t)kind * b_k;
        u.kind = kind; u.keep = kind; return true;
    }
};

typedef __bf16 bf16x2_t __attribute__((ext_vector_type(2)));
__device__ __forceinline__ unsigned cvt_pk_bf16(float lo, float hi) { f32x2 v = {lo, hi}; bf16x2_t b = __builtin_convertvector(v, bf16x2_t); return __builtin_bit_cast(unsigned, b); }
__device__ __forceinline__ u32x4 pack8(const f32x4 v0, const f32x4 v1) { u32x4 w; w.x = cvt_pk_bf16(v0[0], v0[1]); w.y = cvt_pk_bf16(v0[2], v0[3]); w.z = cvt_pk_bf16(v1[0], v1[1]); w.w = cvt_pk_bf16(v1[2], v1[3]); return w; }
__device__ __forceinline__ float bf_lo(unsigned w) { return __uint_as_float(w << 16); }
__device__ __forceinline__ float bf_hi(unsigned w) { return __uint_as_float(w & 0xffff0000u); }
__device__ __forceinline__ void unpack8(const u32x4 w, f32x4& v0, f32x4& v1) { v0 = (f32x4){bf_lo(w.x), bf_hi(w.x), bf_lo(w.y), bf_hi(w.y)}; v1 = (f32x4){bf_lo(w.z), bf_hi(w.z), bf_lo(w.w), bf_hi(w.w)}; }
__device__ __forceinline__ float sigmoidf_(float x) { return __builtin_amdgcn_rcpf(1.0f + __builtin_amdgcn_exp2f(-1.4426950408889634f * x)); }
__device__ __forceinline__ f32x4 sigmoid4(const f32x4 x) { return (f32x4){sigmoidf_(x[0]), sigmoidf_(x[1]), sigmoidf_(x[2]), sigmoidf_(x[3])}; }
__device__ __forceinline__ float gelu_t(float x) { const float u = x * (1.0f + 0.044715f * x * x); return x * __builtin_amdgcn_rcpf(1.0f + __builtin_amdgcn_exp2f(-2.302208198f * u)); }
__device__ __forceinline__ f32x4 gelu4(const f32x4 x) { return (f32x4){gelu_t(x[0]), gelu_t(x[1]), gelu_t(x[2]), gelu_t(x[3])}; }

typedef f32x4 Acc[2][2][4][2];

struct EpiInProj {
    static constexpr bool PERM = true, AFTER_DRAIN = false;
    bf16_t *AP, *Q, *K, *V, *G0, *G1; const float *ropeC, *ropeS, *bgate; float qscale;
    __device__ __forceinline__ void operator()(Acc& acc, const Unit& u, int wr, int wc, int fr, int fq) const {
        { int l_ = (int)threadIdx.x; asm volatile("" : "+v"(l_)); fr = l_ & 15; fq = (l_ >> 4) & 3; }
        const int pn = u.pn, row0 = u.pm * BM + wr * 64 + fr;
        if (pn < 2) {
#pragma unroll
            for (int ai = 0; ai < 2; ++ai)
#pragma unroll
                for (int m = 0; m < 4; ++m) { const int row = row0 + ai * HALF + m * 16, b = row >> 12, t = row & 4095, c = t >> 4, tt = t & 15;
#pragma unroll
                    for (int bj = 0; bj < 2; ++bj) { const int col = pn * BM + bj * HALF + wc * 32 + 8 * fq, g = col >> 4, h0 = col & 15;
                        *(u32x4*)(AP + ((size_t)(g * 2048 + b * 256 + c) * 384 + tt * 16 + h0)) = pack8(acc[ai][bj][m][0], acc[ai][bj][m][1]); } }
        } else if (pn < 6) {
            bf16_t* base = (pn < 4) ? Q : K; const float sc = (pn < 4) ? qscale : 1.0f; const int colb = (pn & 1) * 256 + wc * 64 + 8 * fq;
#pragma unroll
            for (int ai = 0; ai < 2; ++ai)
#pragma unroll
                for (int m = 0; m < 4; ++m) { const int row = row0 + ai * HALF + m * 16, pos = row & 4095;
                    const f32x4 c0 = *(const f32x4*)(ropeC + pos * 32 + 8 * fq), c1 = *(const f32x4*)(ropeC + pos * 32 + 8 * fq + 4);
                    const f32x4 s0 = *(const f32x4*)(ropeS + pos * 32 + 8 * fq), s1 = *(const f32x4*)(ropeS + pos * 32 + 8 * fq + 4);
                    const f32x4 a0 = acc[ai][0][m][0], a1 = acc[ai][0][m][1], b0 = acc[ai][1][m][0], b1 = acc[ai][1][m][1];
                    const f32x4 o10 = (a0 * c0 - b0 * s0) * sc, o11 = (a1 * c1 - b1 * s1) * sc, o20 = (b0 * c0 + a0 * s0) * sc, o21 = (b1 * c1 + a1 * s1) * sc;
                    bf16_t* rp = base + (size_t)row * 512 + colb;
                    *(u32x4*)(rp) = pack8(o10, o11); *(u32x4*)(rp + 32) = pack8(o20, o21); }
        } else if (pn < 8) {
#pragma unroll
            for (int ai = 0; ai < 2; ++ai)
#pragma unroll
                for (int m = 0; m < 4; ++m) { bf16_t* rp = V + (size_t)(row0 + ai * HALF + m * 16) * 512 + (pn - 6) * BM + wc * 32 + 8 * fq;
#pragma unroll
                    for (int bj = 0; bj < 2; ++bj) *(u32x4*)(rp + bj * HALF) = pack8(acc[ai][bj][m][0], acc[ai][bj][m][1]); }
        } else {
            const int gi = (pn - 8) >> 2, colg = ((pn - 8) & 3) * BM + wc * 32 + 8 * fq; bf16_t* base = gi ? G1 : G0; const float* bb = bgate + gi * 1024 + colg;
            f32x4 bv[2][2];
#pragma unroll
            for (int bj = 0; bj < 2; ++bj)
#pragma unroll
                for (int n = 0; n < 2; ++n) bv[bj][n] = *(const f32x4*)(bb + bj * HALF + 4 * n);
#pragma unroll
            for (int ai = 0; ai < 2; ++ai)
#pragma unroll
                for (int m = 0; m < 4; ++m) { bf16_t* rp = base + (size_t)(row0 + ai * HALF + m * 16) * 1024 + colg;
#pragma unroll
                    for (int bj = 0; bj < 2; ++bj) *(u32x4*)(rp + bj * HALF) = pack8(sigmoid4(acc[ai][bj][m][0] + bv[bj][0]), sigmoid4(acc[ai][bj][m][1] + bv[bj][1])); }
        }
    }
};
struct EpiSsmInc {
    static constexpr bool PERM = false, AFTER_DRAIN = false;
    float* I;
    __device__ __forceinline__ void operator()(Acc& acc, const Unit& u, int wr, int wc, int fr, int fq) const {
        { int l_ = (int)threadIdx.x; asm volatile("" : "+v"(l_)); fr = l_ & 15; fq = (l_ >> 4) & 3; }
#pragma unroll
        for (int ai = 0; ai < 2; ++ai)
#pragma unroll
            for (int m = 0; m < 4; ++m) { float* rp = I + (size_t)(u.pm * BM + ai * HALF + wr * 64 + m * 16 + fr) * 128 + wc * 32 + 4 * fq;
#pragma unroll
                for (int n = 0; n < 2; ++n) *(f32x4*)(rp + 16 * n) = acc[ai][0][m][n]; }
    }
};
struct EpiSsmOut {
    static constexpr bool PERM = true, AFTER_DRAIN = false;
    bf16_t* YG;
    __device__ __forceinline__ void operator()(Acc& acc, const Unit& u, int wr, int wc, int fr, int fq) const {
        { int l_ = (int)threadIdx.x; asm volatile("" : "+v"(l_)); fr = l_ & 15; fq = (l_ >> 4) & 3; }
        const int g = u.pm >> 3;
#pragma unroll
        for (int ai = 0; ai < 2; ++ai)
#pragma unroll
            for (int m = 0; m < 4; ++m) { const int rr = (u.pm & 7) * BM + ai * HALF + wr * 64 + m * 16 + fr, b = rr >> 8, c = rr & 255;
#pragma unroll
                for (int bj = 0; bj < 2; ++bj) { const int col = bj * HALF + wc * 32 + 8 * fq, tt = col >> 4, ho = col & 15;
                    *(u32x4*)(YG + (size_t)(b * 4096 + c * 16 + tt) * 512 + g * 16 + ho) = pack8(gelu4(acc[ai][bj][m][0]), gelu4(acc[ai][bj][m][1])); }
                asm volatile("" ::: "memory"); }
    }
};
template <bool SILU_A> struct EpiGlu {
    static constexpr bool PERM = true, AFTER_DRAIN = false;
    bf16_t* O; int ldc;
    __device__ __forceinline__ void operator()(Acc& acc, const Unit& u, int wr, int wc, int fr, int fq) const {
        { int l_ = (int)threadIdx.x; asm volatile("" : "+v"(l_)); fr = l_ & 15; fq = (l_ >> 4) & 3; }
#pragma unroll
        for (int ai = 0; ai < 2; ++ai)
#pragma unroll
            for (int m = 0; m < 4; ++m) { bf16_t* rp = O + (size_t)(u.pm * BM + ai * HALF + wr * 64 + m * 16 + fr) * ldc + u.pn * HALF + wc * 32 + 8 * fq;
                f32x4 o[2];
#pragma unroll
                for (int n = 0; n < 2; ++n) { const f32x4 a = acc[ai][0][m][n], b = acc[ai][1][m][n]; o[n] = SILU_A ? (a * sigmoid4(a)) * b : a * sigmoid4(b); }
                *(u32x4*)rp = pack8(o[0], o[1]); }
    }
};
struct EpiMerge {
    static constexpr bool PERM = true, AFTER_DRAIN = false;
    const bf16_t *G0, *G1; bf16_t* O;
    __device__ __forceinline__ void operator()(Acc& acc, const Unit& u, int wr, int wc, int fr, int fq) const {
        { int l_ = (int)threadIdx.x; asm volatile("" : "+v"(l_)); fr = l_ & 15; fq = (l_ >> 4) & 3; }
#pragma unroll
        for (int ai = 0; ai < 2; ++ai)
#pragma unroll
            for (int m = 0; m < 4; ++m) { const size_t off = (size_t)(u.pm * BM + ai * HALF + wr * 64 + m * 16 + fr) * 1024 + u.pn * BM + wc * 32 + 8 * fq;
#pragma unroll
                for (int bj = 0; bj < 2; ++bj) {
                    f32x4 g1a, g1b; unpack8(*(const u32x4*)(G1 + off + bj * HALF), g1a, g1b);
                    if (u.kind == 0) { f32x4 g0a, g0b; unpack8(*(const u32x4*)(G0 + off + bj * HALF), g0a, g0b);
#pragma unroll
                        for (int j = 0; j < 4; ++j) { acc[ai][bj][m][0][j] *= g0a[j] * __builtin_amdgcn_rcpf(g1a[j]); acc[ai][bj][m][1][j] *= g0b[j] * __builtin_amdgcn_rcpf(g1b[j]); }
                    } else { *(u32x4*)(O + off + bj * HALF) = pack8(acc[ai][bj][m][0] * g1a, acc[ai][bj][m][1] * g1b); } } }
    }
};
struct EpiRes {
    static constexpr bool PERM = false, AFTER_DRAIN = false;
    const float* base; float* out; float alpha;
    __device__ __forceinline__ void operator()(Acc& acc, const Unit& u, int wr, int wc, int fr, int fq) const {
        { int l_ = (int)threadIdx.x; asm volatile("" : "+v"(l_)); fr = l_ & 15; fq = (l_ >> 4) & 3; }
#pragma unroll
        for (int ai = 0; ai < 2; ++ai)
#pragma unroll
            for (int m = 0; m < 4; ++m) { const size_t off = (size_t)(u.pm * BM + ai * HALF + wr * 64 + m * 16 + fr) * 1024 + u.pn * BM + wc * 32 + 4 * fq;
#pragma unroll
                for (int bj = 0; bj < 2; ++bj)
#pragma unroll
                    for (int n = 0; n < 2; ++n) { const f32x4 bs = *(const f32x4*)(base + off + bj * HALF + n * 16); *(f32x4*)(out + off + bj * HALF + n * 16) = bs * alpha + acc[ai][bj][m][n]; } }
    }
};

template <class Epi, class Sched, bool ALIGN_EPI>
__device__ __forceinline__ void gemm_phase(PG8_LAS unsigned char* lds, const Gemm g, const Sched& S, const Epi& E) {
    int tid_ = threadIdx.x; asm volatile("" : "+v"(tid_));
    const int tid = tid_, wid = __builtin_amdgcn_readfirstlane(tid >> 6), lane = tid & 63, wr = wid >> 2, wc = wid & 3, fr = lane & 15, fq = lane >> 4;
    const int nt = g.K / BK;
    unsigned voffA[2], voffB[2];
#pragma unroll
    for (int i = 0; i < 2; ++i) { int R, C; stage_rc(tid * 16 + i * 8192, R, C); const int Rb = Epi::PERM ? ((R & ~31) + perm32(R & 31)) : R;
        voffA[i] = (unsigned)(R * g.lda + C) * 2u; voffB[i] = (unsigned)(Rb * g.ldb + C) * 2u; }
    const size_t kstep = (size_t)(BK * 2);
    const size_t hstepA = (size_t)HALF * g.lda * 2, hstepB = (size_t)HALF * g.ldb * 2;
    const unsigned ldsw = (unsigned)wid * 1024u;
    const int aoff = lds_byte(wr * 64 + fr, fq * 8), boff = lds_byte(wc * 32 + fr, fq * 8);
#define PG8_SA(b, h) (((b) * 2 + (h)) * HTB)
#define PG8_SB(b, h) ((4 + (b) * 2 + (h)) * HTB)
#define PG8_STAGE(bufoff, gbase, voff) do { _Pragma("unroll") for (int _i = 0; _i < 2; ++_i) \
        __builtin_amdgcn_global_load_lds((const unsigned*)((const char*)(gbase) + (voff)[_i]), (PG8_LAS unsigned*)(lds + (bufoff) + ldsw + _i * 8192), 16, 0, 0); } while (0)
#define PG8_LDA(dst, b, h) do { _Pragma("unroll") for (int m = 0; m < 4; ++m) _Pragma("unroll") for (int k = 0; k < 2; ++k) dst[m][k] = *(const PG8_LAS bf16x8*)(lds + PG8_SA(b, h) + aoff + m * 2048 + k * 1024); } while (0)
#define PG8_LDB(dst, b, h) do { _Pragma("unroll") for (int n = 0; n < 2; ++n) _Pragma("unroll") for (int k = 0; k < 2; ++k) dst[n][k] = *(const PG8_LAS bf16x8*)(lds + PG8_SB(b, h) + boff + n * 2048 + k * 1024); } while (0)
#define PG8_MMA(ai, bj, At, Bt) do { __builtin_amdgcn_s_setprio(1); _Pragma("unroll") for (int m = 0; m < 4; ++m) _Pragma("unroll") for (int n = 0; n < 2; ++n) _Pragma("unroll") for (int k = 0; k < 2; ++k) \
        acc[ai][bj][m][n] = __builtin_amdgcn_mfma_f32_16x16x32_bf16(Bt[n][k], At[m][k], acc[ai][bj][m][n], 0, 0, 0); __builtin_amdgcn_s_setprio(0); } while (0)
#define PG8_WAIT_V(n) asm volatile("s_waitcnt vmcnt(" #n ")" ::: "memory")
#define PG8_WAIT_L(n) asm volatile("s_waitcnt lgkmcnt(" #n ")" ::: "memory")
#define PG8_BAR __builtin_amdgcn_s_barrier()
#define PG8_SCHED __builtin_amdgcn_sched_barrier(0)
#define PG8_ZERO() do { _Pragma("unroll") for (int a_ = 0; a_ < 2; ++a_) _Pragma("unroll") for (int b_ = 0; b_ < 2; ++b_) _Pragma("unroll") for (int m_ = 0; m_ < 4; ++m_) _Pragma("unroll") for (int n_ = 0; n_ < 2; ++n_) acc[a_][b_][m_][n_] = (f32x4){0.f, 0.f, 0.f, 0.f}; } while (0)
    Unit cur, nxt; int ui = 0;
    if (!S.next(0, cur)) return;
    Acc acc;
    PG8_ZERO();
    bf16x8 At[4][2], B0[2][2], B1[2][2];
    const char* cA = cur.a; const char* cB = cur.b;
    PG8_STAGE(PG8_SB(0, 0), cB, voffB); PG8_STAGE(PG8_SB(0, 1), cB + hstepB, voffB); PG8_STAGE(PG8_SA(0, 0), cA, voffA); PG8_STAGE(PG8_SA(0, 1), cA + hstepA, voffA);
    if (wr == 1) PG8_BAR;
    PG8_WAIT_V(2); PG8_BAR;
    PG8_STAGE(PG8_SB(1, 0), cB + kstep, voffB); PG8_STAGE(PG8_SA(1, 0), cA + kstep, voffA); PG8_STAGE(PG8_SB(1, 1), cB + hstepB + kstep, voffB);
    PG8_WAIT_V(6); PG8_BAR;
    for (;;) {
        const bool has_next = S.next(ui + 1, nxt);
        const char* nA = has_next ? nxt.a : cA; const char* nB = has_next ? nxt.b : cB;
#pragma unroll 1
        for (int t = 0; t < nt; t += 2) {
            const bool last = (t == nt - 2);
            const char* a1 = cA + (size_t)(t + 1) * kstep;
            const char* a2 = last ? nA : cA + (size_t)(t + 2) * kstep; const char* b2 = last ? nB : cB + (size_t)(t + 2) * kstep;
            const char* a3 = a2 + kstep; const char* b3 = b2 + kstep;
            PG8_LDB(B0, 0, 0); PG8_LDB(B1, 0, 1); PG8_SCHED; PG8_LDA(At, 0, 0); PG8_STAGE(PG8_SA(1, 1), a1 + hstepA, voffA);
            PG8_WAIT_V(8); PG8_WAIT_L(0); PG8_BAR; PG8_MMA(0, 0, At, B0); PG8_MMA(0, 1, At, B1); PG8_BAR; PG8_SCHED;
            PG8_LDA(At, 0, 1); PG8_STAGE(PG8_SB(0, 0), b2, voffB); PG8_STAGE(PG8_SB(0, 1), b2 + hstepB, voffB); PG8_STAGE(PG8_SA(0, 0), a2, voffA);
            PG8_WAIT_V(8); PG8_WAIT_L(0); PG8_BAR; PG8_MMA(1, 0, At, B0); PG8_MMA(1, 1, At, B1); PG8_BAR; PG8_SCHED;
            PG8_LDB(B0, 1, 0); PG8_LDB(B1, 1, 1); PG8_SCHED; PG8_LDA(At, 1, 0); PG8_STAGE(PG8_SA(0, 1), a2 + hstepA, voffA);
            PG8_WAIT_V(8); PG8_WAIT_L(0); PG8_BAR; PG8_MMA(0, 0, At, B0); PG8_MMA(0, 1, At, B1); PG8_BAR; PG8_SCHED;
            PG8_LDA(At, 1, 1); PG8_STAGE(PG8_SB(1, 0), b3, voffB); PG8_STAGE(PG8_SB(1, 1), b3 + hstepB, voffB); PG8_STAGE(PG8_SA(1, 0), a3, voffA);
            PG8_WAIT_V(8); PG8_WAIT_L(0); PG8_BAR; PG8_MMA(1, 0, At, B0); PG8_MMA(1, 1, At, B1); PG8_BAR; PG8_SCHED;
        }
        if constexpr (ALIGN_EPI) { if (wr == 0) PG8_BAR; }
        E(acc, cur, wr, wc, fr, fq);
        if (!has_next) break;
        if (!nxt.keep) PG8_ZERO();
        cur = nxt; cA = nA; cB = nB; ++ui;
        if constexpr (ALIGN_EPI) { if (wr == 1) PG8_BAR; }
    }
    PG8_WAIT_V(0);
    if constexpr (!ALIGN_EPI) { if (wr == 0) PG8_BAR; }
    PG8_BAR;
#undef PG8_SA
#undef PG8_SB
#undef PG8_STAGE
#undef PG8_LDA
#undef PG8_LDB
#undef PG8_MMA
#undef PG8_WAIT_V
#undef PG8_WAIT_L
#undef PG8_BAR
#undef PG8_SCHED
#undef PG8_ZERO
}
}

#include <hip/hip_bf16.h>
#include <cmath>
namespace attn_body {
using bf16=__hip_bfloat16;
using bf16x8=__attribute__((ext_vector_type(8)))short;
using s16x4=__attribute__((ext_vector_type(4)))short;
using f32x16=__attribute__((ext_vector_type(16)))float;
using u32x4=__attribute__((ext_vector_type(4)))unsigned;
constexpr int SEQ=4096,D=64,QP=512,OP=1024;
constexpr int NW=8,QBLK=32,QB=QBLK*NW,KVBLK=64,NQB=SEQ/QB;
constexpr int ATTN_UNIT_ROWS=QB;
__device__ __forceinline__ int crow(int r,int hi){return (r&3)+8*(r>>2)+4*hi;}
#define SBAR() __builtin_amdgcn_sched_barrier(0)
__device__ __forceinline__ void cmask(f32x16&p0,f32x16&p1,int jb,int qrel,int hi){
  const float NEG=-INFINITY; int kb=64*jb+4*hi;
  #pragma unroll
  for(int r=0;r<16;++r){int kv=kb+(r&3)+8*(r>>2); if(kv>qrel)p0[r]=NEG; if(kv+32>qrel)p1[r]=NEG;}
}

constexpr int NSLOT=3, SLOTB=8192;
constexpr int LDS_K=0, LDS_V=NSLOT*SLOTB, LDS_WS=2*NSLOT*SLOTB, LDS_OST=LDS_WS+NW*64*4, LDS_BYTES=LDS_OST+NW*4096;
constexpr float C2=0.125f*1.4426950408889634f;
__device__ __forceinline__ void glds16(const void*gsrc,unsigned lds_dst){unsigned keep;
  asm volatile("s_mov_b32 %0, m0\n\ts_mov_b32 m0, %2\n\ts_nop 0\n\tglobal_load_lds_dwordx4 %1, off\n\ts_mov_b32 m0, %0":"=&s"(keep):"v"(gsrc),"s"(lds_dst):"memory");}
__device__ __forceinline__ float max3f(float a,float b,float c){float r;asm("v_max3_f32 %0, %1, %2, %3":"=v"(r):"v"(a),"v"(b),"v"(c));return r;}
__device__ __forceinline__ float max2f(float a,float b){float r;asm("v_max_f32_e32 %0, %1, %2":"=v"(r):"v"(a),"v"(b));return r;}
__device__ __forceinline__ float fadd_s(float a,float b){float r;asm("v_add_f32_e32 %0, %1, %2":"=v"(r):"v"(a),"v"(b));return r;}
__device__ __forceinline__ float fsub_s(float a,float b){float r;asm("v_sub_f32_e32 %0, %1, %2":"=v"(r):"v"(a),"v"(b));return r;}
typedef float f32x2_t __attribute__((ext_vector_type(2))); typedef __bf16 bf16x2_t __attribute__((ext_vector_type(2)));
__device__ __forceinline__ unsigned cvtpk_s(float lo,float hi){f32x2_t v={lo,hi};bf16x2_t b=__builtin_convertvector(v,bf16x2_t);return __builtin_bit_cast(unsigned,b);}
#define WAIT_BAR(N) asm volatile("s_waitcnt vmcnt(" #N ") lgkmcnt(0)\n\ts_barrier":::"memory")

__device__ __forceinline__ void qkt(f32x16&p0,f32x16&p1,const char*Kslot,const bf16x8*qr,const f32x16&negm,int r32,int hi){
  const char*kb=Kslot+hi*1024+r32*16;
  #pragma unroll
  for(int d0=0;d0<4;++d0){
    const bf16x8 b0=*reinterpret_cast<const bf16x8*>(kb+d0*2048);
    const bf16x8 b1=*reinterpret_cast<const bf16x8*>(kb+d0*2048+512);
    if(d0==0){p0=__builtin_amdgcn_mfma_f32_32x32x16_bf16(b0,qr[0],negm,0,0,0);p1=__builtin_amdgcn_mfma_f32_32x32x16_bf16(b1,qr[0],negm,0,0,0);}
    else{p0=__builtin_amdgcn_mfma_f32_32x32x16_bf16(b0,qr[d0],p0,0,0,0);p1=__builtin_amdgcn_mfma_f32_32x32x16_bf16(b1,qr[d0],p1,0,0,0);}}
}
typedef __attribute__((address_space(3))) const char* lds_cptr;
typedef short v4i16_t __attribute__((ext_vector_type(4)));
__device__ __forceinline__ void kload8(bf16x8*kf,lds_cptr kp){
  kf[0]=*(const __attribute__((address_space(3))) bf16x8*)(kp);      kf[1]=*(const __attribute__((address_space(3))) bf16x8*)(kp+512);
  kf[2]=*(const __attribute__((address_space(3))) bf16x8*)(kp+2048); kf[3]=*(const __attribute__((address_space(3))) bf16x8*)(kp+2560);
  kf[4]=*(const __attribute__((address_space(3))) bf16x8*)(kp+4096); kf[5]=*(const __attribute__((address_space(3))) bf16x8*)(kp+4608);
  kf[6]=*(const __attribute__((address_space(3))) bf16x8*)(kp+6144); kf[7]=*(const __attribute__((address_space(3))) bf16x8*)(kp+6656);
}
__device__ __forceinline__ void kload2(bf16x8*kf,lds_cptr kp,int j){ kf[2*j]=*(const __attribute__((address_space(3))) bf16x8*)(kp+j*2048); kf[2*j+1]=*(const __attribute__((address_space(3))) bf16x8*)(kp+j*2048+512); }
__device__ __forceinline__ s16x4 vtr(lds_cptr p){ return __builtin_bit_cast(s16x4,__builtin_amdgcn_ds_read_tr16_b64_v4i16((__attribute__((address_space(3))) v4i16_t*)p)); }
__device__ __forceinline__ float rowmax(const f32x16&p0,const f32x16&p1){
  float a=max3f(p0[0],p0[1],p1[0]),b=max3f(p0[2],p0[3],p1[1]);a=max3f(a,p1[2],p1[3]);
  #pragma unroll
  for(int r=4;r<16;r+=4){a=max3f(a,p0[r],p0[r+1]);b=max3f(b,p0[r+2],p0[r+3]);a=max3f(a,p1[r],p1[r+1]);b=max3f(b,p1[r+2],p1[r+3]);}
  const float m=max2f(a,b);
  auto rr=__builtin_amdgcn_permlane32_swap(__float_as_uint(m),__float_as_uint(m),false,false);
  return max2f(__uint_as_float(rr[0]),__uint_as_float(rr[1]));
}
__device__ __forceinline__ void pv(f32x16*o,int vb,bf16x8 pa0,bf16x8 pa1,bf16x8 pa2,bf16x8 pa3){
  #pragma unroll
  for(int d0=0;d0<2;++d0){s16x4 lo[4],hi[4];
    #pragma unroll
    for(int ks=0;ks<4;++ks){
      asm volatile("ds_read_b64_tr_b16 %0,%1 offset:%c2":"=&v"(lo[ks]):"v"(vb),"i"(d0*4096+ks*1024):"memory");
      asm volatile("ds_read_b64_tr_b16 %0,%1 offset:%c2":"=&v"(hi[ks]):"v"(vb),"i"(d0*4096+ks*1024+512):"memory");}
    asm volatile("s_waitcnt lgkmcnt(0)":::"memory");SBAR();
    #define PK(k) (bf16x8){lo[k][0],lo[k][1],lo[k][2],lo[k][3],hi[k][0],hi[k][1],hi[k][2],hi[k][3]}
    o[d0]=__builtin_amdgcn_mfma_f32_32x32x16_bf16(pa0,PK(0),o[d0],0,0,0);
    o[d0]=__builtin_amdgcn_mfma_f32_32x32x16_bf16(pa1,PK(1),o[d0],0,0,0);
    o[d0]=__builtin_amdgcn_mfma_f32_32x32x16_bf16(pa2,PK(2),o[d0],0,0,0);
    o[d0]=__builtin_amdgcn_mfma_f32_32x32x16_bf16(pa3,PK(3),o[d0],0,0,0);
    #undef PK
  }
}

#ifndef ATTN_STORE16
#define ATTN_STORE16(p,v) (*(u32x4*)(p)=(v))
#endif
template<int THRL> __device__ __forceinline__ void attn_unit(int b,int qcol,int vcol,int ocol,int qb,const bf16*Q,const bf16*__restrict__ K,const bf16*__restrict__ V,bf16*O,char*shm){
  int tid_l=threadIdx.x; asm volatile("":"+v"(tid_l));   const int tid=tid_l,lane=tid&63,r32=lane&31,hi=lane>>5; const int wid=__builtin_amdgcn_readfirstlane(tid>>6);
  const long rowbase=(long)b*SEQ; const int q0=qb*QB;
  const bf16*Qw=Q+(rowbase+q0+wid*QBLK)*QP+qcol;
  const bf16*Kh=K+rowbase*QP+qcol,*Vh=V+rowbase*QP+vcol;
  const unsigned lds0=(unsigned)(uintptr_t)shm;
  float*wsf=(float*)(shm+LDS_WS)+wid*64;
  const bf16*ksrc=Kh+(long)lane*QP+wid*8;
  const bf16*vsrc=Vh+(long)(16*(wid&3)+(lane>>2))*QP+(wid>>2)*32+(lane&3)*8;
  const unsigned kdst=lds0+LDS_K+wid*1024, vdst=lds0+LDS_V+wid*1024;
  #define DMA_K(t,slot) glds16(ksrc+(long)(t)*KVBLK*QP,(unsigned)__builtin_amdgcn_readfirstlane(kdst+(slot)))
  #define DMA_V(t,slot) glds16(vsrc+(long)(t)*KVBLK*QP,(unsigned)__builtin_amdgcn_readfirstlane(vdst+(slot)))
  const int vb0=(int)(lds0+LDS_V)+((lane>>4)&1)*32+(lane&3)*8+(4*hi+((lane&15)>>2))*64;
  const char*Kbase=shm+LDS_K; bf16x8 kf[8];
  const lds_cptr shm3=(lds_cptr)shm; const lds_cptr kp0=shm3+LDS_K+hi*1024+r32*16; const lds_cptr vp0=shm3+LDS_V+((lane>>4)&1)*32+(lane&3)*8+(4*hi+((lane&15)>>2))*64;
  const int NT=(q0+QB)/KVBLK;
  DMA_K(0,0);DMA_V(0,0);DMA_K(1,SLOTB);
  bf16x8 qr[4];
  #pragma unroll
  for(int d0=0;d0<4;++d0)qr[d0]=*reinterpret_cast<const bf16x8*>(&Qw[(long)r32*QP+d0*16+hi*8]);
  float mhat=0.f,l_reg=0.f;f32x16 o[2];o[0]=f32x16{};o[1]=f32x16{};f32x16 negm=f32x16{};asm volatile("":"+v"(negm));
  const int qrel=wid*QBLK+r32;
  #define CMASK(P0,P1,t) do{int jb_=(t)-(NT-4); if(jb_>=0)cmask(P0,P1,jb_,qrel,hi);}while(0)
  bool resc=false;
  #define START(P0,P1) do{ const float rm=rowmax(P0,P1); resc=false; \
    { const float dl=rm; mhat=fadd_s(mhat,dl); \
      _Pragma("unroll") for(int r=0;r<16;++r){P0[r]=fsub_s(P0[r],dl);P1[r]=fsub_s(P1[r],dl);} \
      _Pragma("unroll") for(int r=0;r<16;++r)negm[r]=-mhat; asm volatile("":"+v"(negm)); } \
    _Pragma("unroll") for(int r=0;r<16;++r)P0[r]=__builtin_amdgcn_exp2f(P0[r]); }while(0)
  #define RESC() do{ if(resc){ asm volatile("s_waitcnt lgkmcnt(0)":::"memory"); \
      _Pragma("unroll") for(int d_=0;d_<2;++d_) _Pragma("unroll") for(int r=0;r<16;++r)o[d_][r]*=wsf[crow(r,hi)]; } }while(0)
  f32x16 pA0,pA1,pB0,pB1;
  int sl_prev=0,sl_cur=0,sl_next=SLOTB;
  #define ROT() do{sl_prev=sl_cur;sl_cur=sl_next;sl_next=(sl_next==(NSLOT-1)*SLOTB)?0:sl_next+SLOTB;}while(0)
  DMA_K(2,2*SLOTB);
  WAIT_BAR(3);
  qkt(pA0,pA1,Kbase,qr,negm,r32,hi);asm volatile("s_nop 15\n\ts_nop 7":"+v"(pA0),"+v"(pA1));CMASK(pA0,pA1,0);
  START(pA0,pA1);
  _Pragma("unroll") for(int r=0;r<16;++r)pA1[r]=__builtin_amdgcn_exp2f(pA1[r]);
  WAIT_BAR(0);
  DMA_K(3,0);DMA_V(1,SLOTB);
  ROT();
  kload8(kf,kp0+sl_cur);
  WAIT_BAR(2);
  s16x4 vlo[8],vhi[8]; u32x4 pw0,pw1,pw2,pw3;
  #define PKW(P,B) cvtpk_s(P[B],P[B+1])
  #define PAF(k) __builtin_bit_cast(bf16x8,pw##k)
  #define VFR(i) (bf16x8){vlo[i][0],vlo[i][1],vlo[i][2],vlo[i][3],vhi[i][0],vhi[i][1],vhi[i][2],vhi[i][3]}
  #define PIN(x) asm volatile("":"+v"(x))
  #define MX3(a,b,c) __builtin_fmaxf(__builtin_fmaxf((a),(b)),(c))
  #define GAPA(MF,A0,A1,A2,A3,W0,W1,PW) do{ MF; sacc+=A0; sacc+=A1; sacc+=A2; sacc+=A3; PIN(sacc); W0; W1; PIN(PW); SBAR(); }while(0)
  #define EX(v) __builtin_amdgcn_exp2f(v)
  #define GAPB(MF,X,B) do{ MF; X[B]=EX(X[B]); X[B+1]=EX(X[B+1]); X[B+2]=EX(X[B+2]); X[B+3]=EX(X[B+3]); PIN(X); SBAR(); }while(0)
  #define VRD(i) do{ vlo[i]=vtr(vp_+(((i)>>2)*4096+((i)&3)*1024)); vhi[i]=vtr(vp_+(((i)>>2)*4096+((i)&3)*1024+512)); }while(0)
  #define KRD(G,j) do{ if(G){ kload2(kf,kp0+sl_next,j); SBAR(); } }while(0)
  #define STEP(C0,C1,P0,P1,t,GK,GV,GL) do{ SBAR(); \
    const lds_cptr vp_=vp0+sl_prev; \
    VRD(0); SBAR(); float sacc=(P0[0]+P0[1]); \
    GAPA(C0=__builtin_amdgcn_mfma_f32_32x32x16_bf16(kf[0],qr[0],negm,0,0,0), P0[2],P0[3],P0[4],P0[5],     pw0[0]=PKW(P0,0), pw0[1]=PKW(P0,2), pw0); \
    VRD(4); SBAR(); GAPA(C1=__builtin_amdgcn_mfma_f32_32x32x16_bf16(kf[1],qr[0],negm,0,0,0), P0[6],P0[7],P0[8],P0[9],     pw0[2]=PKW(P0,4), pw0[3]=PKW(P0,6), pw0); \
    VRD(1); SBAR(); GAPA(C0=__builtin_amdgcn_mfma_f32_32x32x16_bf16(kf[2],qr[1],C0,0,0,0),   P0[10],P0[11],P0[12],P0[13], pw1[0]=PKW(P0,8), pw1[1]=PKW(P0,10), pw1); \
    VRD(5); SBAR(); GAPA(C1=__builtin_amdgcn_mfma_f32_32x32x16_bf16(kf[3],qr[1],C1,0,0,0),   P0[14],P0[15],P1[0],P1[1],   pw1[2]=PKW(P0,12),pw1[3]=PKW(P0,14), pw1); \
    VRD(2); SBAR(); GAPA(C0=__builtin_amdgcn_mfma_f32_32x32x16_bf16(kf[4],qr[2],C0,0,0,0),   P1[2],P1[3],P1[4],P1[5],     pw2[0]=PKW(P1,0), pw2[1]=PKW(P1,2), pw2); \
    VRD(6); SBAR(); GAPA(C1=__builtin_amdgcn_mfma_f32_32x32x16_bf16(kf[5],qr[2],C1,0,0,0),   P1[6],P1[7],P1[8],P1[9],     pw2[2]=PKW(P1,4), pw2[3]=PKW(P1,6), pw2); \
    VRD(3); SBAR(); GAPA(C0=__builtin_amdgcn_mfma_f32_32x32x16_bf16(kf[6],qr[3],C0,0,0,0),   P1[10],P1[11],P1[12],P1[13], pw3[0]=PKW(P1,8), pw3[1]=PKW(P1,10), pw3); \
    VRD(7); SBAR(); GAPA(C1=__builtin_amdgcn_mfma_f32_32x32x16_bf16(kf[7],qr[3],C1,0,0,0),   P1[14],P1[15],0.f,0.f,       pw3[2]=PKW(P1,12),pw3[3]=PKW(P1,14), pw3); \
    l_reg+=sacc; \
    if(GK){DMA_K((t)+3,sl_cur);} if(GV){DMA_V((t)+1,sl_next);} \
    CMASK(C0,C1,t); \
    { float a=MX3(C0[0],C0[1],C1[0]),b=MX3(C0[2],C0[3],C1[1]); a=MX3(a,C1[2],C1[3]); \
      _Pragma("unroll") for(int r=4;r<16;r+=4){a=MX3(a,C0[r],C0[r+1]);b=MX3(b,C0[r+2],C0[r+3]);a=MX3(a,C1[r],C1[r+1]);b=MX3(b,C1[r+2],C1[r+3]);} \
      float rm=__builtin_fmaxf(a,b); { auto rr=__builtin_amdgcn_permlane32_swap(__float_as_uint(rm),__float_as_uint(rm),false,false); rm=__builtin_fmaxf(__uint_as_float(rr[0]),__uint_as_float(rr[1])); } \
      resc=false; \
      if(__builtin_expect(__any(rm>(float)THRL),0)){ const float dl=__builtin_fmaxf(rm,0.f); mhat+=dl; \
        _Pragma("unroll") for(int r=0;r<16;++r){C0[r]-=dl;C1[r]-=dl;} \
        _Pragma("unroll") for(int r=0;r<16;++r)negm[r]=-mhat; asm volatile("":"+v"(negm)); \
        const float f=__builtin_amdgcn_exp2f(-dl); l_reg*=f; if(hi==0)wsf[r32]=f; resc=true; } } \
    SBAR(); \
    GAPB(o[0]=__builtin_amdgcn_mfma_f32_32x32x16_bf16(PAF(0),VFR(0),o[0],0,0,0), C0,0); \
    GAPB(o[1]=__builtin_amdgcn_mfma_f32_32x32x16_bf16(PAF(0),VFR(4),o[1],0,0,0), C0,4); \
    KRD(GL,0); GAPB(o[0]=__builtin_amdgcn_mfma_f32_32x32x16_bf16(PAF(1),VFR(1),o[0],0,0,0), C0,8); \
    KRD(GL,1); GAPB(o[1]=__builtin_amdgcn_mfma_f32_32x32x16_bf16(PAF(1),VFR(5),o[1],0,0,0), C0,12); \
    KRD(GL,2); GAPB(o[0]=__builtin_amdgcn_mfma_f32_32x32x16_bf16(PAF(2),VFR(2),o[0],0,0,0), C1,0); \
    KRD(GL,3); GAPB(o[1]=__builtin_amdgcn_mfma_f32_32x32x16_bf16(PAF(2),VFR(6),o[1],0,0,0), C1,4); \
    GAPB(o[0]=__builtin_amdgcn_mfma_f32_32x32x16_bf16(PAF(3),VFR(3),o[0],0,0,0), C1,8); \
    GAPB(o[1]=__builtin_amdgcn_mfma_f32_32x32x16_bf16(PAF(3),VFR(7),o[1],0,0,0), C1,12); \
    }while(0)
  int t=1;
  #undef CMASK
  #define CMASK(P0,P1,t) do{}while(0)
  for(;t+5<NT;t+=2){
    STEP(pB0,pB1,pA0,pA1,t,true,true,true);     WAIT_BAR(2); RESC(); ROT();
    STEP(pA0,pA1,pB0,pB1,t+1,true,true,true);   WAIT_BAR(2); RESC(); ROT();
  }
  #undef CMASK
  #define CMASK(P0,P1,t) do{int jb_=(t)-(NT-4); if(jb_>=0)cmask(P0,P1,jb_,qrel,hi);}while(0)
  #define ENDW(tt) do{ if((tt)+3<NT){WAIT_BAR(2);} else if((tt)+2<NT){WAIT_BAR(1);} else {WAIT_BAR(0);} }while(0)
  for(;t+1<NT;t+=2){
    STEP(pB0,pB1,pA0,pA1,t,(t+3<NT),(t+1<NT),(t+1<NT));       ENDW(t);   RESC(); ROT();
    STEP(pA0,pA1,pB0,pB1,t+1,(t+4<NT),(t+2<NT),(t+2<NT));     ENDW(t+1); RESC(); ROT();
  }
  STEP(pB0,pB1,pA0,pA1,NT-1,false,false,false); RESC();
  { float sacc=pB0[0]+pB0[1]; _Pragma("unroll") for(int r=2;r<16;++r)sacc+=pB0[r]; _Pragma("unroll") for(int r=0;r<16;++r)sacc+=pB1[r]; l_reg+=sacc;
    pw0=(u32x4){PKW(pB0,0),PKW(pB0,2),PKW(pB0,4),PKW(pB0,6)};pw1=(u32x4){PKW(pB0,8),PKW(pB0,10),PKW(pB0,12),PKW(pB0,14)};pw2=(u32x4){PKW(pB1,0),PKW(pB1,2),PKW(pB1,4),PKW(pB1,6)};pw3=(u32x4){PKW(pB1,8),PKW(pB1,10),PKW(pB1,12),PKW(pB1,14)};
    SBAR(); pv(o,vb0+sl_cur,PAF(0),PAF(1),PAF(2),PAF(3)); }
  #undef PKW
  #undef PAF
  #undef VFR
  #undef PIN
  #undef MX3
  #undef GAPA
  #undef GAPB
  #undef EX
  #undef VRD
  #undef KRD
  #undef STEP
  #undef ENDW
  {auto rr=__builtin_amdgcn_permlane32_swap(__float_as_uint(l_reg),__float_as_uint(l_reg),false,false);l_reg=__uint_as_float(rr[0])+__uint_as_float(rr[1]);}
  if(hi==0)wsf[32+r32]=l_reg;asm volatile("s_waitcnt lgkmcnt(0)":::"memory");
  float rli[16];
  #pragma unroll
  for(int r=0;r<16;++r)rli[r]=__builtin_amdgcn_rcpf(wsf[32+crow(r,hi)]);
  bf16*Ow=O+(rowbase+q0+wid*QBLK)*OP+ocol;
  { bf16*stg=(bf16*)(shm+LDS_OST)+wid*2048;
    #pragma unroll
    for(int r=0;r<16;++r){const int orow=crow(r,hi);
      #pragma unroll
      for(int d0=0;d0<2;++d0)stg[orow*64+d0*32+r32]=__float2bfloat16(o[d0][r]*rli[r]);}
    asm volatile("s_waitcnt lgkmcnt(0)":::"memory");
    #pragma unroll
    for(int i=0;i<4;++i){const int row=i*8+(lane>>3),ch=lane&7; const u32x4 v=*(const u32x4*)(stg+row*64+ch*8); ATTN_STORE16(Ow+(long)row*OP+ch*8,v);} }
  asm volatile("s_waitcnt lgkmcnt(0)\n\ts_barrier":::"memory");
  #undef DMA_K
  #undef DMA_V
  #undef CMASK
  #undef START
  #undef RESC
  #undef ROT
}
constexpr int ATTN_LDS_BYTES=LDS_BYTES;
#undef SBAR
#undef WAIT_BAR
}

constexpr int NWAVES = 8;
constexpr int BATCH = 8, SEQ = 4096, DMOD = 1024, M = BATCH * SEQ, DIN = 4096, DFF = 2816;
constexpr float LN_EPS = 1e-5f, RMS_EPS = 1e-5f, ALPHA = 1.189207115002721f, LAMBDA_INIT = 0.2f;
constexpr float QSCALE = 0.125f * 1.4426950408889634f;
constexpr size_t MiB = 1u << 20;
constexpr size_t WS_CTL = 0, CTL_BYTES = 16384;
constexpr size_t WS_WIN = 1 * MiB, WS_WGLU = 9 * MiB, WS_WP = 10 * MiB, WS_WOUT = 12 * MiB, WS_WGU = 14 * MiB, WS_WD = 25 * MiB, WS_TP = 31 * MiB, WS_BS = 37 * MiB, WS_ROPE = 41 * MiB, WS_A16 = 42 * MiB;
constexpr size_t WS_XB = 48 * MiB, WS_CAT = 48 * MiB, WS_ACT = 48 * MiB, WS_G0 = 112 * MiB, WS_G1 = 176 * MiB, WS_Q = 240 * MiB, WS_K = 272 * MiB, WS_V = 304 * MiB, WS_AP = 336 * MiB, WS_I = 384 * MiB,
                 WS_YG = 416 * MiB, WS_O = 448 * MiB, WS_MRG = 240 * MiB, WS_X1 = 304 * MiB, WS_X1B = 432 * MiB, WS_END = 512 * MiB;
constexpr int RING_BYTES = 131072, LDS_BYTES = 147456;

#define GAS __attribute__((address_space(1)))
#define LAS __attribute__((address_space(3)))
typedef unsigned short bf16;
typedef unsigned v4u __attribute__((ext_vector_type(4)));
typedef float f32x4 __attribute__((ext_vector_type(4)));
#define LDS_WAIT() asm volatile("s_waitcnt lgkmcnt(0)" ::: "memory")
__device__ __forceinline__ unsigned f2bf(float f) { unsigned u = __builtin_bit_cast(unsigned, f); return (u + 0x7fffu + ((u >> 16) & 1u)) >> 16; }
__device__ __forceinline__ unsigned pk2(float lo, float hi) { return f2bf(lo) | (f2bf(hi) << 16); }
__device__ __forceinline__ float wave_sum(float v) {
#pragma unroll
    for (int o = 1; o < 64; o <<= 1) v += __shfl_xor(v, o);
    return v;
}

#define RLX_AGENT __ATOMIC_RELAXED, __HIP_MEMORY_SCOPE_AGENT
#define XB_TMO      128
#define XB_XCNT(j)  (256  + 64 * (j))
#define XB_XSUB(j)  (1280 + 64 * (j))
#define XB_XGEN(j)  (2304 + 64 * (j))
#define XB_TOP      3328
#define XB_TOPGEN   3392
#define XCD_BAR_WORDS 3456
#define XB_SPIN_CAP (1u << 18)

__device__ __forceinline__ unsigned xb_ld(unsigned* p)              { return __hip_atomic_load(p, __ATOMIC_RELAXED, __HIP_MEMORY_SCOPE_AGENT); }
__device__ __forceinline__ unsigned xb_add(unsigned* p, unsigned v) { return __hip_atomic_fetch_add(p, v, __ATOMIC_RELAXED, __HIP_MEMORY_SCOPE_AGENT); }
__device__ __forceinline__ unsigned xb_xcc_id() { return (unsigned)__builtin_amdgcn_s_getreg((3 << 11) | 20) & 0xFu; }
#define XB_SPIN(cond, bar) do { unsigned _sp = 0; while (cond) { __builtin_amdgcn_s_sleep(1); \
    if ((++_sp & 255u) == 0u) { if (xb_ld(&(bar)[XB_TMO])) break; if (_sp > XB_SPIN_CAP) { atomicAdd(&(bar)[XB_TMO], 1u); break; } } } } while (0)

struct XcdBarrier {
    unsigned* bar; unsigned x;
    volatile LAS unsigned* st;
};

__device__ __forceinline__ XcdBarrier xcd_barrier_post(unsigned* bar, volatile LAS unsigned* st) {
    XcdBarrier b; b.bar = bar; b.x = xb_xcc_id(); b.st = st;
    if (threadIdx.x == 0) (void)xb_add(&bar[XB_XCNT(b.x)], 1u);
    return b;
}
__device__ __forceinline__ void xcd_barrier_complete(unsigned* bar, unsigned x, unsigned& nloc, unsigned& nx) {
    const unsigned G = gridDim.x * gridDim.y * gridDim.z;
    unsigned sum, cnt, mine, sp = 0u;
    for (;;) {
        sum = 0u; cnt = 0u; mine = 0u;
#pragma unroll
        for (unsigned j = 0; j < 16; ++j) { const unsigned c = xb_ld(&bar[XB_XCNT(j)]); sum += c; cnt += (c > 0u) ? 1u : 0u; mine = (j == x) ? c : mine; }
        if (sum == G) break;
        __builtin_amdgcn_s_sleep(1);
        if ((++sp & 255u) == 0u) { if (xb_ld(&bar[XB_TMO])) break; if (sp > XB_SPIN_CAP) { atomicAdd(&bar[XB_TMO], 1u); break; } }
    }
    nloc = mine > 0u ? mine : 1u; nx = cnt > 0u ? cnt : 1u;
}

__device__ __forceinline__ void xcd_barrier(const XcdBarrier& b) {
    asm volatile("s_waitcnt vmcnt(0)" ::: "memory");
    __syncthreads();
    if (threadIdx.x == 0) {
        unsigned* bar = b.bar;
        __builtin_amdgcn_s_waitcnt(0);
        unsigned nloc = b.st[0], nx = b.st[1];
        if (nloc == 0u) { xcd_barrier_complete(bar, b.x, nloc, nx); b.st[0] = nloc; b.st[1] = nx; }
        const unsigned old = xb_add(&bar[XB_XSUB(b.x)], 1u);
        const unsigned gen = old / nloc;
        if (old + 1u == (gen + 1u) * nloc) {
            __builtin_amdgcn_fence(__ATOMIC_RELEASE, "agent");
            asm volatile("s_waitcnt vmcnt(0)" ::: "memory");
            const unsigned og = xb_add(&bar[XB_TOP], 1u);
            const unsigned tg = og / nx;
            if (og + 1u == (tg + 1u) * nx) xb_add(&bar[XB_TOPGEN], 1u);
            else XB_SPIN(xb_ld(&bar[XB_TOPGEN]) == tg, bar);
            __builtin_amdgcn_fence(__ATOMIC_ACQUIRE, "agent");
            xb_add(&bar[XB_XGEN(b.x)], 1u);
            asm volatile("s_waitcnt vmcnt(0)" ::: "memory");
        } else {
            XB_SPIN(xb_ld(&bar[XB_XGEN(b.x)]) == gen, bar);
            __builtin_amdgcn_fence(__ATOMIC_ACQUIRE, "agent");
            asm volatile("s_waitcnt vmcnt(0)" ::: "memory");
        }
    }
    __syncthreads();
}

struct Args { const float* in[27]; float* out; unsigned char* ws; int ph_lo, ph_hi; };

__device__ __forceinline__ int ltid() { int t = threadIdx.x; asm volatile("" : "+v"(t)); return t; }
struct Frame {
    LAS unsigned char* lds;
    int wave, vcu, G;
    const Args* a; unsigned char* ws;
};

__device__ __forceinline__ void cexpd(double zr, double zi, double& er, double& ei) {
    const double z = zr * 0.0625; double e = 1.0;
#pragma unroll
    for (int k = 14; k >= 1; --k) e = 1.0 + e * z / (double)k;
    e = e * e; e = e * e; e = e * e; e = e * e;
    double rev = zi * 0.15915494309189535; rev -= rint(rev);
    const double q = rint(rev * 4.0); const double y = (rev - q * 0.25) * 6.283185307179586;
    const double y2 = y * y;
    const double sn = y * (1.0 + y2 * (-1.0 / 6 + y2 * (1.0 / 120 + y2 * (-1.0 / 5040 + y2 * (1.0 / 362880 + y2 * (-1.0 / 39916800 + y2 * (1.0 / 6227020800.0)))))));
    const double cs = 1.0 + y2 * (-0.5 + y2 * (1.0 / 24 + y2 * (-1.0 / 720 + y2 * (1.0 / 40320 + y2 * (-1.0 / 3628800 + y2 * (1.0 / 479001600.0 + y2 * (-1.0 / 87178291200.0)))))));
    const int qi = ((int)q) & 3;
    const double c = (qi == 0) ? cs : (qi == 1) ? -sn : (qi == 2) ? -cs : sn;
    const double s = (qi == 0) ? sn : (qi == 1) ? cs : (qi == 2) ? -sn : -cs;
    er = e * c; ei = e * s;
}

__device__ __forceinline__ void p0_transpose_item(const float* W, int N, bf16* WT, int ldt, int koff, int k0, int n0, int drow0, LAS float* scr, int lane) {
#pragma unroll 8
    for (int i = 0; i < 32; ++i) { const int kk = 2 * i + (lane >> 5); scr[kk * 33 + (lane & 31)] = W[(size_t)(k0 + kk) * N + n0 + (lane & 31)]; }
    LDS_WAIT(); asm volatile("" ::: "memory");
    const int c = lane & 7;
#pragma unroll
    for (int j = 0; j < 4; ++j) { const int n = (lane >> 3) + 8 * j; const LAS float* s = scr + (8 * c) * 33 + n;
        v4u o; o.x = pk2(s[0 * 33], s[1 * 33]); o.y = pk2(s[2 * 33], s[3 * 33]); o.z = pk2(s[4 * 33], s[5 * 33]); o.w = pk2(s[6 * 33], s[7 * 33]);
        *(GAS v4u*)(WT + (size_t)(drow0 + n) * ldt + koff + k0 + 8 * c) = o; }
    LDS_WAIT(); asm volatile("" ::: "memory");
}
__device__ __forceinline__ int glu_row(int n0) { return 256 * (n0 >> 7) + (n0 & 127); }
__device__ __forceinline__ void p0_weight(const float* W, int Ks, int N, bf16* WT, int ldt, int koff, int mode, int item, LAS float* scr, int lane) {
    const int nblk = N / 32, kb = item / nblk, nb = item - kb * nblk, n0 = 32 * nb; int drow0 = n0;
    if (mode == 1) { if (n0 >= 512 && n0 < 1536) { const int r = n0 - 512, tq = r >> 8, mp = (r >> 6) & 3, hf = (r >> 5) & 1; drow0 = 512 + 256 * tq + 128 * hf + 32 * mp; } }
    else if (mode == 2) { drow0 = (n0 < 512) ? glu_row(n0) : glu_row(n0 - 512) + 128; }
    else if (mode == 3) drow0 = glu_row(n0);
    else if (mode == 4) drow0 = glu_row(n0) + 128;
    p0_transpose_item(W, N, WT, ldt, koff, 64 * kb, n0, drow0, scr, lane);
}
__device__ __forceinline__ void p0_build_ssm(Frame& F, int g) {
    const float* lam_re = F.a->in[3]; const float* lam_im = F.a->in[4]; const float* log_step = F.a->in[5];
    const float* b_re = F.a->in[6]; const float* b_im = F.a->in[7]; const float* c_re = F.a->in[8]; const float* c_im = F.a->in[9]; const float* dsk = F.a->in[10];
    LAS float* L = (LAS float*)F.lds;
    LAS float* PWr = L;            LAS float* PWi = L + 17 * 64;
    LAS float* BBr = L + 2176;     LAS float* BBi = L + 2176 + 1024;
    LAS float* Cr = L + 4224;      LAS float* Ci = L + 4224 + 1024;
    LAS float* KT = L + 6272;
    const int tid = ltid(), p = tid & 63, part = tid >> 6;
    {
        const double lr = (double)lam_re[g * 64 + p], li = (double)lam_im[g * 64 + p], dt = (double)__expf(log_step[g]);
        for (int tau = part; tau < 17; tau += 8) { double er, ei; cexpd(lr * dt * tau, li * dt * tau, er, ei); PWr[tau * 64 + p] = (float)er; PWi[tau * 64 + p] = (float)ei;
            if (tau == 16) { float* A16 = (float*)(F.ws + WS_A16); A16[(g * 64 + p) * 2] = (float)er; A16[(g * 64 + p) * 2 + 1] = (float)ei; } }
        double ar, ai; cexpd(lr * dt, li * dt, ar, ai);
        const double nr = ar - 1.0, ni = ai, den = lr * lr + li * li, fr = (nr * lr + ni * li) / den, fi = (ni * lr - nr * li) / den;
#pragma unroll
        for (int hh = 0; hh < 2; ++hh) { const int hi = part * 2 + hh; const double br = (double)b_re[(g * 64 + p) * 16 + hi], bi = (double)b_im[(g * 64 + p) * 16 + hi];
            BBr[p * 16 + hi] = (float)(fr * br - fi * bi); BBi[p * 16 + hi] = (float)(fr * bi + fi * br); }
        Cr[tid] = c_re[g * 1024 + tid]; Cr[tid + 512] = c_re[g * 1024 + tid + 512]; Ci[tid] = c_im[g * 1024 + tid]; Ci[tid + 512] = c_im[g * 1024 + tid + 512];
    }
    __syncthreads();
    for (int j = 0; j < 8; ++j) { const int o = tid + 512 * j, tau = o >> 8, ho = (o >> 4) & 15, hi = o & 15; float s = 0.f;
        for (int q = 0; q < 64; ++q) { const float cr = Cr[ho * 64 + q], ci = Ci[ho * 64 + q], pr = PWr[tau * 64 + q], pi = PWi[tau * 64 + q];
            const float xr = cr * pr - ci * pi, xi = cr * pi + ci * pr; s += xr * BBr[q * 16 + hi] - xi * BBi[q * 16 + hi]; }
        if (tau == 0 && ho == hi) s += dsk[g * 16 + ho];
        KT[o] = s; }
    __syncthreads();
    bf16* TP = (bf16*)(F.ws + WS_TP) + (size_t)g * 256 * 384; bf16* BS = (bf16*)(F.ws + WS_BS) + (size_t)g * 256 * 256;
    for (int ch = tid; ch < 256 * 48; ch += 512) { const int n = ch / 48, kc = ch - n * 48, k0 = 8 * kc, tt = n >> 4, ho = n & 15; float v[8];
        if (k0 < 256) { const int ss = k0 >> 4, hi0 = k0 & 15;
#pragma unroll
            for (int j = 0; j < 8; ++j) v[j] = (tt >= ss) ? KT[((tt - ss) * 16 + ho) * 16 + hi0 + j] : 0.f;
        } else { const bool im = k0 >= 320; const int p0 = k0 - (im ? 320 : 256);
#pragma unroll
            for (int j = 0; j < 8; ++j) { const float cr = Cr[ho * 64 + p0 + j], ci = Ci[ho * 64 + p0 + j], pr = PWr[(tt + 1) * 64 + p0 + j], pi = PWi[(tt + 1) * 64 + p0 + j];
                v[j] = im ? -(cr * pi + ci * pr) : (cr * pr - ci * pi); } }
        v4u o; o.x = pk2(v[0], v[1]); o.y = pk2(v[2], v[3]); o.z = pk2(v[4], v[5]); o.w = pk2(v[6], v[7]);
        *(GAS v4u*)(TP + (size_t)n * 384 + k0) = o; }
    for (int ch = tid; ch < 256 * 32; ch += 512) { const int n = ch >> 5, kc = ch & 31, k0 = 8 * kc, ss = k0 >> 4, hi0 = k0 & 15; float v[8];
        if (n < 128) { const int q = n & 63; const bool im = n >= 64; const float pr = PWr[(15 - ss) * 64 + q], pi = PWi[(15 - ss) * 64 + q];
#pragma unroll
            for (int j = 0; j < 8; ++j) { const float br = BBr[q * 16 + hi0 + j], bi = BBi[q * 16 + hi0 + j]; v[j] = im ? (pr * bi + pi * br) : (pr * br - pi * bi); }
        } else {
#pragma unroll
            for (int j = 0; j < 8; ++j) v[j] = 0.f; }
        v4u o; o.x = pk2(v[0], v[1]); o.y = pk2(v[2], v[3]); o.z = pk2(v[4], v[5]); o.w = pk2(v[6], v[7]);
        *(GAS v4u*)(BS + (size_t)n * 256 + k0) = o; }
    __syncthreads();
}
__device__ __forceinline__ void p0_prologue(Frame& F) {
    const int tid = ltid(), lane = tid & 63;
    for (int g = blockIdx.x; g < 32; g += F.G) p0_build_ssm(F, g);
    LAS float* scr = (LAS float*)(F.lds + F.wave * 16384);
    const int gw = F.vcu * NWAVES + F.wave, NGW = F.G * NWAVES;
    constexpr int I_IN = 16 * 128, I_GLU = 8 * 32, I_PS = 8 * 32, I_PA = 8 * 32, I_OUT = 16 * 32, I_G = 16 * 88, I_U = 16 * 88, I_D = 44 * 32;
    constexpr int NITEMS = I_IN + I_GLU + I_PS + I_PA + I_OUT + I_G + I_U + I_D;
    const float* const* in = F.a->in; unsigned char* ws = F.ws;
    for (int it = gw; it < NITEMS; it += NGW) {
        int r = it;
        if (r < I_IN) { p0_weight(in[1], 1024, 4096, (bf16*)(ws + WS_WIN), 1024, 0, 1, r, scr, lane); continue; } r -= I_IN;
        if (r < I_GLU) { p0_weight(in[11], 512, 1024, (bf16*)(ws + WS_WGLU), 512, 0, 2, r, scr, lane); continue; } r -= I_GLU;
        if (r < I_PS) { p0_weight(in[17], 512, 1024, (bf16*)(ws + WS_WP), 1024, 0, 0, r, scr, lane); continue; } r -= I_PS;
        if (r < I_PA) { p0_weight(in[18], 512, 1024, (bf16*)(ws + WS_WP), 1024, 512, 0, r, scr, lane); continue; } r -= I_PA;
        if (r < I_OUT) { p0_weight(in[19], 1024, 1024, (bf16*)(ws + WS_WOUT), 1024, 0, 0, r, scr, lane); continue; } r -= I_OUT;
        if (r < I_G) { p0_weight(in[22], 1024, 2816, (bf16*)(ws + WS_WGU), 1024, 0, 3, r, scr, lane); continue; } r -= I_G;
        if (r < I_U) { p0_weight(in[23], 1024, 2816, (bf16*)(ws + WS_WGU), 1024, 0, 4, r, scr, lane); continue; } r -= I_U;
        p0_weight(in[24], 2816, 1024, (bf16*)(ws + WS_WD), 2816, 0, 0, r, scr, lane);
    }
    { float* rc = (float*)(ws + WS_ROPE); float* rs = rc + 4096 * 32;
      for (int i = blockIdx.x * 512 + tid; i < 4096 * 32; i += F.G * 512) { const int pos = i >> 5, dd = i & 31; double fr_, fi_, er, ei; cexpd(-0.28782313662425574 * (double)dd, 0.0, fr_, fi_); cexpd(0.0, (double)pos * fr_, er, ei); rc[i] = (float)er; rs[i] = (float)ei; } }
    { const float* x = in[0]; bf16* XB = (bf16*)(ws + WS_XB);
      for (int m = gw; m < M; m += NGW) { const GAS f32x4* xr = (const GAS f32x4*)(x + (size_t)m * 1024) + lane; GAS unsigned long long* o8 = (GAS unsigned long long*)(XB + (size_t)m * 1024) + lane;
#pragma unroll
          for (int j = 0; j < 4; ++j) { const f32x4 v = xr[64 * j]; o8[64 * j] = (unsigned long long)pk2(v.x, v.y) | ((unsigned long long)pk2(v.z, v.w) << 32); } } }
}
__device__ __forceinline__ void ssm_scan(Frame& F) {
    LAS float* TW = (LAS float*)F.lds;
    const float* A16 = (const float*)(F.ws + WS_A16); const float* I = (const float*)(F.ws + WS_I); bf16* AP = (bf16*)(F.ws + WS_AP);
    for (int bg = blockIdx.x; bg < 256; bg += F.G) {
        const int g = bg >> 3, b = bg & 7, p = ltid() & 63, w = F.wave;
        const float ar = A16[(g * 64 + p) * 2], ai = A16[(g * 64 + p) * 2 + 1];
        const float* Ip = I + (size_t)(g * 2048 + b * 256 + 32 * w) * 128 + p;
        float xr[32], xi[32];
#pragma unroll
        for (int j = 0; j < 32; ++j) { xr[j] = Ip[j * 128]; xi[j] = Ip[j * 128 + 64]; }
        float sr = 0.f, si = 0.f;
#pragma unroll
        for (int j = 0; j < 32; ++j) { const float nr = ar * sr - ai * si + xr[j], ni = ar * si + ai * sr + xi[j]; sr = nr; si = ni; xr[j] = sr; xi[j] = si; }
        TW[(w * 64 + p) * 2] = sr; TW[(w * 64 + p) * 2 + 1] = si;
        __syncthreads();
        float qr = ar, qi = ai;
#pragma unroll
        for (int k = 0; k < 5; ++k) { const float t = qr * qr - qi * qi; qi = 2.f * qr * qi; qr = t; }
        float cr = 0.f, ci = 0.f;
        for (int w2 = 0; w2 < w; ++w2) { const float tr = TW[(w2 * 64 + p) * 2], ti = TW[(w2 * 64 + p) * 2 + 1]; const float nr = qr * cr - qi * ci + tr, ni = qr * ci + qi * cr + ti; cr = nr; ci = ni; }
        bf16* dst = AP + (size_t)(g * 2048 + b * 256 + 32 * w + 1) * 384 + 256 + p;
#pragma unroll
        for (int j = 0; j < 32; ++j) { const float t = ar * cr - ai * ci; ci = ar * ci + ai * cr; cr = t;
            if (32 * w + j + 1 < 256) { dst[(size_t)j * 384] = (bf16)f2bf(xr[j] + cr); dst[(size_t)j * 384 + 64] = (bf16)f2bf(xi[j] + ci); } }
        if (w == 0) { bf16* d0 = AP + (size_t)(g * 2048 + b * 256) * 384 + 256 + p; d0[0] = 0; d0[64] = 0; }
        __syncthreads();
    }
}
__device__ __forceinline__ void attn_combine(Frame& F) {
    const int lane = ltid() & 63;
    const float* const* in = F.a->in;
    const float d1 = wave_sum(in[12][lane] * in[13][lane]), d2 = wave_sum(in[14][lane] * in[15][lane]);
    const float lam = __expf(d1) - __expf(d2) + LAMBDA_INIT;
    const int gw = F.vcu * NWAVES + F.wave, NGW = F.G * NWAVES, h = lane >> 4, e0 = (lane & 15) * 8;
    const bf16* O = (const bf16*)(F.ws + WS_O); bf16* CAT = (bf16*)(F.ws + WS_CAT);
    f32x4 ga = *(const f32x4*)(in[16] + e0), gb = *(const f32x4*)(in[16] + e0 + 4);
    ga = ga * (1.0f - LAMBDA_INIT); gb = gb * (1.0f - LAMBDA_INIT);
    for (int m = gw; m < M; m += NGW) {
        const v4u w1 = *(const GAS v4u*)(O + (size_t)m * 1024 + h * 256 + e0), w2 = *(const GAS v4u*)(O + (size_t)m * 1024 + h * 256 + 128 + e0);
        f32x4 a0, a1, b0, b1; pg8::unpack8(w1, a0, a1); pg8::unpack8(w2, b0, b1);
        const f32x4 o0 = a0 - b0 * lam, o1 = a1 - b1 * lam;
        float ss = (o0[0] * o0[0] + o0[1] * o0[1]) + (o0[2] * o0[2] + o0[3] * o0[3]) + (o1[0] * o1[0] + o1[1] * o1[1]) + (o1[2] * o1[2] + o1[3] * o1[3]);
        ss += __shfl_xor(ss, 1); ss += __shfl_xor(ss, 2); ss += __shfl_xor(ss, 4); ss += __shfl_xor(ss, 8);
        const float r = 1.0f / sqrtf(ss * (1.0f / 128.0f) + RMS_EPS);
        *(GAS v4u*)(CAT + (size_t)m * 1024 + 512 + h * 128 + e0) = pg8::pack8(o0 * r * ga, o1 * r * gb);
    }
}
__device__ __forceinline__ void ln_rows(Frame& F, float* X, const float* gam, const float* bet, bf16* XBo) {
    const int lane = ltid() & 63;
    const int gw = F.vcu * NWAVES + F.wave, NGW = F.G * NWAVES;
    f32x4 gv[4], bv[4];
#pragma unroll
    for (int j = 0; j < 4; ++j) { gv[j] = *(const f32x4*)(gam + 4 * lane + 256 * j); bv[j] = *(const f32x4*)(bet + 4 * lane + 256 * j); }
    for (int m = gw; m < M; m += NGW) {
        GAS f32x4* xr = (GAS f32x4*)(X + (size_t)m * 1024) + lane;
        f32x4 v[4]; float s = 0.f;
#pragma unroll
        for (int j = 0; j < 4; ++j) { v[j] = xr[64 * j]; s += (v[j].x + v[j].y) + (v[j].z + v[j].w); }
        const float mean = wave_sum(s) * (1.f / 1024.f); float s2 = 0.f;
#pragma unroll
        for (int j = 0; j < 4; ++j) { v[j] = v[j] - mean; s2 += (v[j].x * v[j].x + v[j].y * v[j].y) + (v[j].z * v[j].z + v[j].w * v[j].w); }
        const float rstd = 1.f / sqrtf(wave_sum(s2) * (1.f / 1024.f) + LN_EPS);
#pragma unroll
        for (int j = 0; j < 4; ++j) { v[j] = v[j] * rstd * gv[j] + bv[j]; xr[64 * j] = v[j]; }
        if (XBo) { GAS unsigned long long* o8 = (GAS unsigned long long*)(XBo + (size_t)m * 1024) + lane;
#pragma unroll
            for (int j = 0; j < 4; ++j) o8[64 * j] = (unsigned long long)pk2(v[j].x, v[j].y) | ((unsigned long long)pk2(v[j].z, v[j].w) << 32); }
    }
}
__device__ __forceinline__ void attn_all(Frame& F, char* lds) {
    const attn_body::bf16* Q = (const attn_body::bf16*)(F.ws + WS_Q); const attn_body::bf16* K = (const attn_body::bf16*)(F.ws + WS_K);
    const attn_body::bf16* V = (const attn_body::bf16*)(F.ws + WS_V); attn_body::bf16* O = (attn_body::bf16*)(F.ws + WS_O);
    for (int j = F.vcu; j < 1024; j += F.G) {
        const int bh = j >> 3, jj = j & 7, b = bh >> 4, hh = bh & 15, head = hh >> 2, mp = (hh >> 1) & 1, vh = hh & 1;
        const int qcol = (head * 2 + mp) * 64, vcol = head * 128 + vh * 64, ocol = ((head * 2 + mp) * 2 + vh) * 64;
        attn_body::attn_unit<8>(b, qcol, vcol, ocol, 15 - jj, Q, K, V, O, lds);
        attn_body::attn_unit<8>(b, qcol, vcol, ocol, jj, Q, K, V, O, lds);
    }
}

constexpr int N_PHASES = 13;
__global__ void __launch_bounds__(NWAVES * 64, 2) fwd_kernel(Args args) {
    extern __shared__ __attribute__((aligned(16))) unsigned char lds[];
    Frame F;
    F.lds = (LAS unsigned char*)lds; F.wave = __builtin_amdgcn_readfirstlane((int)threadIdx.x >> 6);
    F.G = gridDim.x; { const int bx = blockIdx.x; F.vcu = (F.G % 8 == 0) ? (bx % 8) * (F.G / 8) + bx / 8 : bx; }
    F.a = &args; F.ws = args.ws;
    unsigned char* ws = args.ws; const float* const* in = args.in;
    const int lo = args.ph_lo, hi = args.ph_hi;
    volatile LAS unsigned* MISC = (volatile LAS unsigned*)(F.lds + RING_BYTES + 320);
    if (threadIdx.x < 32) MISC[threadIdx.x] = 0u;
    __syncthreads();
    XcdBarrier bar; bar.bar = (unsigned*)(ws + WS_CTL); bar.x = 0; bar.st = nullptr;
    if (hi - lo > 1) {
        cg::this_grid().sync();
        bar = xcd_barrier_post((unsigned*)(ws + WS_CTL), MISC + 8);
    }
#ifndef PHMASK
#define PHMASK 0x1fff
#endif
#define IN(k) (((PHMASK >> (k)) & 1) && lo <= (k) && (k) < hi)
#define SEAM(k) do { if (IN(k) && IN((k) + 1)) { xcd_barrier(bar); } } while (0)
    typedef pg8::bf16_t pb;
    const int cblk = (int)blockIdx.x;

    if (IN(0)) { p0_prologue(F); }
    SEAM(0);
    if (IN(1)) {
        pg8::Gemm g{1024, 1024, 1024};
        pg8::TileOrder S{M / 256, 16, (M / 256) * 16, F.G, cblk, 1, 0, (const char*)(ws + WS_XB), (const char*)(ws + WS_WIN), (size_t)256 * 1024 * 2, (size_t)256 * 1024 * 2, 0, 0};
        pg8::EpiInProj E{(pb*)(ws + WS_AP), (pb*)(ws + WS_Q), (pb*)(ws + WS_K), (pb*)(ws + WS_V), (pb*)(ws + WS_G0), (pb*)(ws + WS_G1), (const float*)(ws + WS_ROPE), (const float*)(ws + WS_ROPE) + 4096 * 32, in[2], QSCALE};
        pg8::gemm_phase<pg8::EpiInProj, pg8::TileOrder, true>(F.lds, g, S, E);
    }
    SEAM(1);
    if (IN(2)) {
        pg8::Gemm g{384, 256, 256};
        pg8::TileOrder S{256, 1, 256, F.G, cblk, 1, 1, (const char*)(ws + WS_AP), (const char*)(ws + WS_BS), (size_t)256 * 384 * 2, (size_t)256 * 256 * 2, 0, 0};
        pg8::EpiSsmInc E{(float*)(ws + WS_I)};
        pg8::gemm_phase<pg8::EpiSsmInc, pg8::TileOrder, true>(F.lds, g, S, E);
    }
    SEAM(2);
    if (IN(3)) { ssm_scan(F); }
    SEAM(3);
    if (IN(4)) {
        pg8::Gemm g{384, 384, 384};
        pg8::TileOrder S{256, 1, 256, F.G, cblk, 1, 1, (const char*)(ws + WS_AP), (const char*)(ws + WS_TP), (size_t)256 * 384 * 2, (size_t)256 * 384 * 2, 0, 0};
        pg8::EpiSsmOut E{(pb*)(ws + WS_YG)};
        pg8::gemm_phase<pg8::EpiSsmOut, pg8::TileOrder, true>(F.lds, g, S, E);
    }
    SEAM(4);
    if (IN(5)) {
        {
            pg8::Gemm g{512, 512, 512};
            pg8::TileOrder S{M / 256, 4, (M / 256) * 4, F.G, cblk, 1, 0, (const char*)(ws + WS_YG), (const char*)(ws + WS_WGLU), (size_t)256 * 512 * 2, (size_t)256 * 512 * 2, 0, 0};
            pg8::EpiGlu<false> E{(pb*)(ws + WS_CAT), 1024};
            pg8::gemm_phase<pg8::EpiGlu<false>, pg8::TileOrder, true>(F.lds, g, S, E);
        }
        attn_all(F, (char*)lds);
    }
    SEAM(5);
    if (IN(6)) { attn_combine(F); }
    SEAM(6);
    if (IN(7)) {
        pg8::Gemm g{1024, 1024, 512};
        pg8::TileOrder S{M / 256, 4, (M / 256) * 4, F.G, cblk, 2, 0, (const char*)(ws + WS_CAT), (const char*)(ws + WS_WP), (size_t)256 * 1024 * 2, (size_t)256 * 1024 * 2, (size_t)512 * 2, (size_t)512 * 2};
        pg8::EpiMerge E{(const pb*)(ws + WS_G0), (const pb*)(ws + WS_G1), (pb*)(ws + WS_MRG)};
        pg8::gemm_phase<pg8::EpiMerge, pg8::TileOrder, true>(F.lds, g, S, E);
    }
    SEAM(7);
    if (IN(8)) {
        pg8::Gemm g{1024, 1024, 1024};
        pg8::TileOrder S{M / 256, 4, (M / 256) * 4, F.G, cblk, 1, 0, (const char*)(ws + WS_MRG), (const char*)(ws + WS_WOUT), (size_t)256 * 1024 * 2, (size_t)256 * 1024 * 2, 0, 0};
        pg8::EpiRes E{in[0], (float*)(ws + WS_X1), ALPHA};
        pg8::gemm_phase<pg8::EpiRes, pg8::TileOrder, true>(F.lds, g, S, E);
    }
    SEAM(8);
    if (IN(9)) { ln_rows(F, (float*)(ws + WS_X1), in[20], in[21], (bf16*)(ws + WS_X1B)); }
    SEAM(9);
    if (IN(10)) {
        pg8::Gemm g{1024, 1024, 1024};
        pg8::TileOrder S{M / 256, 22, (M / 256) * 22, F.G, cblk, 1, 0, (const char*)(ws + WS_X1B), (const char*)(ws + WS_WGU), (size_t)256 * 1024 * 2, (size_t)256 * 1024 * 2, 0, 0};
        pg8::EpiGlu<true> E{(pb*)(ws + WS_ACT), DFF};
        pg8::gemm_phase<pg8::EpiGlu<true>, pg8::TileOrder, true>(F.lds, g, S, E);
    }
    SEAM(10);
    if (IN(11)) {
        pg8::Gemm g{DFF, DFF, DFF};
        pg8::TileOrder S{M / 256, 4, (M / 256) * 4, F.G, cblk, 1, 0, (const char*)(ws + WS_ACT), (const char*)(ws + WS_WD), (size_t)256 * DFF * 2, (size_t)256 * DFF * 2, 0, 0};
        pg8::EpiRes E{(const float*)(ws + WS_X1), args.out, ALPHA};
        pg8::gemm_phase<pg8::EpiRes, pg8::TileOrder, true>(F.lds, g, S, E);
    }
    SEAM(11);
    if (IN(12)) { ln_rows(F, args.out, in[25], in[26], nullptr); }
#undef IN
#undef SEAM
}


#ifdef DBG_CK
__global__ void ck_kernel(const unsigned* p, size_t nwords, unsigned* out) {
    unsigned s = 0; for (size_t i = (size_t)blockIdx.x * blockDim.x + threadIdx.x; i < nwords; i += (size_t)gridDim.x * blockDim.x) s += p[i] * ((unsigned)i * 2654435761u | 1u);
#pragma unroll
    for (int o = 32; o >= 1; o >>= 1) s += __shfl_xor(s, o);
    if ((threadIdx.x & 63) == 0) atomicAdd(out, s);
}
__global__ void fin_kernel(const unsigned* cs, float* out, int n) {
    const int i = blockIdx.x * blockDim.x + threadIdx.x; if (i < n) out[i] = 0.f;
    if (i == 0) { int k; for (k = 0; k < 13; ++k) if (cs[k] != cs[16 + k]) break; int mask = 0; for (int r = 0; r < 5; ++r) if (cs[32 + r] != cs[40 + r]) mask |= 1 << r; out[0] = (k < 13) ? 1000.f * (float)(k + 1) : 0.f; out[1] = 100.f * (float)mask; (void)k; if (k == 1) out[0] = 100.f * (float)mask + 50000.f; }
}
#endif
extern "C" void kernel_launch(void* const* d_in, const int* in_sizes, int n_in, void* d_out, int out_size, void* d_ws, size_t ws_size, hipStream_t stream) {
    static int grid = 0;
    if (grid == 0) {
        if (n_in != 27 || in_sizes[0] != M * DMOD || out_size != M * DMOD || ws_size < WS_END) { fprintf(stderr, "kernel_launch: unexpected shapes (n_in %d, in0 %d, out %d, ws %zu)\n", n_in, n_in > 0 ? in_sizes[0] : -1, out_size, ws_size); grid = -1; return; }
        int dev = 0, cus = 0, per_cu = 0;
        if (hipGetDevice(&dev) != hipSuccess || hipDeviceGetAttribute(&cus, hipDeviceAttributeMultiprocessorCount, dev) != hipSuccess) { grid = -1; return; }
        if (hipFuncSetAttribute((const void*)fwd_kernel, hipFuncAttributeMaxDynamicSharedMemorySize, LDS_BYTES) != hipSuccess) { fprintf(stderr, "kernel_launch: hipFuncSetAttribute failed\n"); grid = -1; return; }
        if (hipOccupancyMaxActiveBlocksPerMultiprocessor(&per_cu, (const void*)fwd_kernel, NWAVES * 64, LDS_BYTES) != hipSuccess || per_cu < 1) { fprintf(stderr, "kernel_launch: occupancy query says %d\n", per_cu); per_cu = 1; }
        (void)hipGetLastError();
        grid = cus;
    }
    if (grid < 0) return;
    if (hipMemsetAsync((char*)d_ws + WS_CTL, 0, CTL_BYTES, stream) != hipSuccess) { fprintf(stderr, "kernel_launch: memset failed\n"); return; }
#ifdef DBG_POISON
    (void)hipMemsetAsync((char*)d_ws + CTL_BYTES, 0xAA, WS_END - CTL_BYTES, stream); (void)hipMemsetAsync(d_out, 0xAA, (size_t)out_size * 4, stream);
#endif
    Args a{};
    for (int i = 0; i < 27; ++i) a.in[i] = (const float*)d_in[i];
    a.out = (float*)d_out; a.ws = (unsigned char*)d_ws;
#if MK_N_LAUNCHES == 1
    a.ph_lo = 0; a.ph_hi = N_PHASES;
    void* kargs[] = {&a};
    hipError_t e = hipLaunchCooperativeKernel((const void*)fwd_kernel, dim3(grid), dim3(NWAVES * 64), kargs, LDS_BYTES, stream);
    if (e != hipSuccess) fprintf(stderr, "kernel_launch: cooperative launch failed: %s (grid %d)\n", hipGetErrorString(e), grid);
#else
#ifdef DBG_CK
    unsigned* cs = (unsigned*)((char*)d_ws + 14400);
    static const size_t roff[13] = {1, 112, 384, 336, 416, 448, 48, 240, 304, 304, 48, 0, 0}, rsz[13] = {42, 224, 32, 48, 32, 64, 64, 64, 128, 192, 176, 0, 0};
    for (int pass = 0; pass < 2; ++pass)
    for (int ph = 0; ph < N_PHASES; ++ph) {
        a.ph_lo = ph; a.ph_hi = ph + 1;
        hipLaunchKernelGGL(fwd_kernel, dim3(grid), dim3(NWAVES * 64), LDS_BYTES, stream, a);
        if (ph == 1) { static const size_t o5[5] = {112, 176, 240, 272, 304}, s5[5] = {64, 64, 32, 32, 32};
            for (int r5 = 0; r5 < 5; ++r5) hipLaunchKernelGGL(ck_kernel, dim3(1024), dim3(256), 0, stream, (const unsigned*)((char*)d_ws + o5[r5] * MiB), s5[r5] * MiB / 4, cs + 32 + pass * 8 + r5); }
        if (ph >= 11) hipLaunchKernelGGL(ck_kernel, dim3(1024), dim3(256), 0, stream, (const unsigned*)d_out, (size_t)out_size, cs + pass * 16 + ph);
        else { hipLaunchKernelGGL(ck_kernel, dim3(1024), dim3(256), 0, stream, (const unsigned*)((char*)d_ws + roff[ph] * MiB), rsz[ph] * MiB / 4, cs + pass * 16 + ph);
               if (ph == 0) hipLaunchKernelGGL(ck_kernel, dim3(1024), dim3(256), 0, stream, (const unsigned*)((char*)d_ws + 48 * MiB), 64 * MiB / 4, cs + pass * 16 + ph); }
    }
    hipLaunchKernelGGL(fin_kernel, dim3((out_size + 255) / 256), dim3(256), 0, stream, (const unsigned*)cs, (float*)d_out, out_size);
#else
    for (int ph = 0; ph < N_PHASES; ++ph) {
        a.ph_lo = ph; a.ph_hi = ph + 1;
        hipLaunchKernelGGL(fwd_kernel, dim3(grid), dim3(NWAVES * 64), LDS_BYTES, stream, a);
    }
#endif
#endif
}
```

```cpp
#include <hip/hip_runtime.h>
#include <hip/hip_cooperative_groups.h>
#include <cstdio>
#include <cstdint>
#include <cmath>
namespace cg = cooperative_groups;


#ifndef MK_N_LAUNCHES
#define MK_N_LAUNCHES 1
#endif

namespace pg8 {
#define PG8_LAS __attribute__((address_space(3)))
typedef unsigned short bf16_t;
typedef short bf16x8 __attribute__((ext_vector_type(8)));
typedef float f32x4 __attribute__((ext_vector_type(4)));
typedef float f32x2 __attribute__((ext_vector_type(2)));
typedef unsigned u32x4 __attribute__((ext_vector_type(4)));
constexpr int BM = 256, BK = 64, HALF = 128, HTB = HALF * BK * 2  , STAGE_BYTES = 8 * HTB, NXCD = 8, WGM = 8;

__host__ __device__ __forceinline__ int lds_byte(int r, int c) { const int st = (r >> 4) * 2 + (c >> 5), rr = r & 15, cc = c & 31, ob = rr * 64 + cc * 2; return st * 1024 + (ob ^ (((ob >> 9) & 1) << 5)); }
__host__ __device__ __forceinline__ void stage_rc(int b, int& R, int& C) { const int st = b / 1024, sb = b % 1024, swz = sb ^ (((sb >> 9) & 1) << 5); R = (st >> 1) * 16 + swz / 64; C = (st & 1) * 32 + (swz % 64) / 2; }
__host__ __device__ __forceinline__ int perm32(int rho) { const int n = rho >> 4, i = rho & 15; return 8 * (i >> 2) + 4 * n + (i & 3); }

struct Unit { const char* a; const char* b; int pm, pn, kind, keep; };
struct Gemm { int lda, ldb, K; };

struct TileOrder {
    int nM, nN, nwg, G, c, chain, grouped; const char* A; const char* B; size_t a_t, b_t, a_k, b_k;
    __device__ __forceinline__ bool next(int i, Unit& u) const {
        const int ti = (chain == 2) ? (i >> 1) : i, kind = (chain == 2) ? (i & 1) : 0;
        const long L = (long)ti * G + c; if (L >= nwg) return false;
        int wgid = (int)L; { const int q = nwg / NXCD, r = nwg % NXCD, xcd = wgid % NXCD, off = wgid / NXCD; wgid = (xcd < r ? xcd * (q + 1) : r * (q + 1) + (xcd - r) * q) + off; }
        const int nig = WGM * nN, gid = wgid / nig, fm = gid * WGM, gsz = (nM - fm) < WGM ? (nM - fm) : WGM;
        u.pm = fm + ((wgid % nig) % gsz); u.pn = (wgid % nig) / gsz;
        u.a = A + (size_t)u.pm * a_t + (size_t)kind * a_k;
        u.b = B + (size_t)(grouped ? (u.pm >> 3) : u.pn) * b_t + (size_t)kind * b_k;
        u.kind = kind; u.keep = kind; return true;
    }
};

typedef __bf16 bf16x2_t __attribute__((ext_vector_type(2)));
__device__ __forceinline__ unsigned cvt_pk_bf16(float lo, float hi) { f32x2 v = {lo, hi}; bf16x2_t b = __builtin_convertvector(v, bf16x2_t); return __builtin_bit_cast(unsigned, b); }
__device__ __forceinline__ u32x4 pack8(const f32x4 v0, const f32x4 v1) { u32x4 w; w.x = cvt_pk_bf16(v0[0], v0[1]); w.y = cvt_pk_bf16(v0[2], v0[3]); w.z = cvt_pk_bf16(v1[0], v1[1]); w.w = cvt_pk_bf16(v1[2], v1[3]); return w; }
__device__ __forceinline__ float bf_lo(unsigned w) { return __uint_as_float(w << 16); }
__device__ __forceinline__ float bf_hi(unsigned w) { return __uint_as_float(w & 0xffff0000u); }
__device__ __forceinline__ void unpack8(const u32x4 w, f32x4& v0, f32x4& v1) { v0 = (f32x4){bf_lo(w.x), bf_hi(w.x), bf_lo(w.y), bf_hi(w.y)}; v1 = (f32x4){bf_lo(w.z), bf_hi(w.z), bf_lo(w.w), bf_hi(w.w)}; }
__device__ __forceinline__ float sigmoidf_(float x) { return __builtin_amdgcn_rcpf(1.0f + __builtin_amdgcn_exp2f(-1.4426950408889634f * x)); }
__device__ __forceinline__ f32x4 sigmoid4(const f32x4 x) { return (f32x4){sigmoidf_(x[0]), sigmoidf_(x[1]), sigmoidf_(x[2]), sigmoidf_(x[3])}; }
__device__ __forceinline__ float gelu_t(float x) { const float u = x * (1.0f + 0.044715f * x * x); return x * __builtin_amdgcn_rcpf(1.0f + __builtin_amdgcn_exp2f(-2.302208198f * u)); }
__device__ __forceinline__ f32x4 gelu4(const f32x4 x) { return (f32x4){gelu_t(x[0]), gelu_t(x[1]), gelu_t(x[2]), gelu_t(x[3])}; }

typedef f32x4 Acc[2][2][4][2];

struct EpiInProj {
    static constexpr bool PERM = true, AFTER_DRAIN = false;
    bf16_t *AP, *Q, *K, *V, *G0, *G1; const float *ropeC, *ropeS, *bgate; float qscale;
    __device__ __forceinline__ void operator()(Acc& acc, const Unit& u, int wr, int wc, int fr, int fq) const {
        { int l_ = (int)threadIdx.x; asm volatile("" : "+v"(l_)); fr = l_ & 15; fq = (l_ >> 4) & 3; }
        const int pn = u.pn, row0 = u.pm * BM + wr * 64 + fr;
        if (pn < 2) {
#pragma unroll
            for (int ai = 0; ai < 2; ++ai)
#pragma unroll
                for (int m = 0; m < 4; ++m) { const int row = row0 + ai * HALF + m * 16, b = row >> 12, t = row & 4095, c = t >> 4, tt = t & 15;
#pragma unroll
                    for (int bj = 0; bj < 2; ++bj) { const int col = pn * BM + bj * HALF + wc * 32 + 8 * fq, g = col >> 4, h0 = col & 15;
                        *(u32x4*)(AP + ((size_t)(g * 2048 + b * 256 + c) * 384 + tt * 16 + h0)) = pack8(acc[ai][bj][m][0], acc[ai][bj][m][1]); } }
        } else if (pn < 6) {
            bf16_t* base = (pn < 4) ? Q : K; const float sc = (pn < 4) ? qscale : 1.0f; const int colb = (pn & 1) * 256 + wc * 64 + 8 * fq;
#pragma unroll
            for (int ai = 0; ai < 2; ++ai)
#pragma unroll
                for (int m = 0; m < 4; ++m) { const int row = row0 + ai * HALF + m * 16, pos = row & 4095;
                    const f32x4 c0 = *(const f32x4*)(ropeC + pos * 32 + 8 * fq), c1 = *(const f32x4*)(ropeC + pos * 32 + 8 * fq + 4);
                    const f32x4 s0 = *(const f32x4*)(ropeS + pos * 32 + 8 * fq), s1 = *(const f32x4*)(ropeS + pos * 32 + 8 * fq + 4);
                    const f32x4 a0 = acc[ai][0][m][0], a1 = acc[ai][0][m][1], b0 = acc[ai][1][m][0], b1 = acc[ai][1][m][1];
                    const f32x4 o10 = (a0 * c0 - b0 * s0) * sc, o11 = (a1 * c1 - b1 * s1) * sc, o20 = (b0 * c0 + a0 * s0) * sc, o21 = (b1 * c1 + a1 * s1) * sc;
                    bf16_t* rp = base + (size_t)row * 512 + colb;
                    *(u32x4*)(rp) = pack8(o10, o11); *(u32x4*)(rp + 32) = pack8(o20, o21); }
        } else if (pn < 8) {
#pragma unroll
            for (int ai = 0; ai < 2; ++ai)
#pragma unroll
                for (int m = 0; m < 4; ++m) { bf16_t* rp = V + (size_t)(row0 + ai * HALF + m * 16) * 512 + (pn - 6) * BM + wc * 32 + 8 * fq;
#pragma unroll
                    for (int bj = 0; bj < 2; ++bj) *(u32x4*)(rp + bj * HALF) = pack8(acc[ai][bj][m][0], acc[ai][bj][m][1]); }
        } else {
            const int gi = (pn - 8) >> 2, colg = ((pn - 8) & 3) * BM + wc * 32 + 8 * fq; bf16_t* base = gi ? G1 : G0; const float* bb = bgate + gi * 1024 + colg;
            f32x4 bv[2][2];
#pragma unroll
            for (int bj = 0; bj < 2; ++bj)
#pragma unroll
                for (int n = 0; n < 2; ++n) bv[bj][n] = *(const f32x4*)(bb + bj * HALF + 4 * n);
#pragma unroll
            for (int ai = 0; ai < 2; ++ai)
#pragma unroll
                for (int m = 0; m < 4; ++m) { bf16_t* rp = base + (size_t)(row0 + ai * HALF + m * 16) * 1024 + colg;
#pragma unroll
                    for (int bj = 0; bj < 2; ++bj) *(u32x4*)(rp + bj * HALF) = pack8(sigmoid4(acc[ai][bj][m][0] + bv[bj][0]), sigmoid4(acc[ai][bj][m][1] + bv[bj][1])); }
        }
    }
};
struct EpiSsmInc {
    static constexpr bool PERM = false, AFTER_DRAIN = false;
    float* I;
    __device__ __forceinline__ void operator()(Acc& acc, const Unit& u, int wr, int wc, int fr, int fq) const {
        { int l_ = (int)threadIdx.x; asm volatile("" : "+v"(l_)); fr = l_ & 15; fq = (l_ >> 4) & 3; }
#pragma unroll
        for (int ai = 0; ai < 2; ++ai)
#pragma unroll
            for (int m = 0; m < 4; ++m) { float* rp = I + (size_t)(u.pm * BM + ai * HALF + wr * 64 + m * 16 + fr) * 128 + wc * 32 + 4 * fq;
#pragma unroll
                for (int n = 0; n < 2; ++n) *(f32x4*)(rp + 16 * n) = acc[ai][0][m][n]; }
    }
};
struct EpiSsmOut {
    static constexpr bool PERM = true, AFTER_DRAIN = false;
    bf16_t* YG;
    __device__ __forceinline__ void operator()(Acc& acc, const Unit& u, int wr, int wc, int fr, int fq) const {
        { int l_ = (int)threadIdx.x; asm volatile("" : "+v"(l_)); fr = l_ & 15; fq = (l_ >> 4) & 3; }
        const int g = u.pm >> 3;
#pragma unroll
        for (int ai = 0; ai < 2; ++ai)
#pragma unroll
            for (int m = 0; m < 4; ++m) { const int rr = (u.pm & 7) * BM + ai * HALF + wr * 64 + m * 16 + fr, b = rr >> 8, c = rr & 255;
#pragma unroll
                for (int bj = 0; bj < 2; ++bj) { const int col = bj * HALF + wc * 32 + 8 * fq, tt = col >> 4, ho = col & 15;
                    *(u32x4*)(YG + (size_t)(b * 4096 + c * 16 + tt) * 512 + g * 16 + ho) = pack8(gelu4(acc[ai][bj][m][0]), gelu4(acc[ai][bj][m][1])); }
                asm volatile("" ::: "memory"); }
    }
};
template <bool SILU_A> struct EpiGlu {
    static constexpr bool PERM = true, AFTER_DRAIN = false;
    bf16_t* O; int ldc;
    __device__ __forceinline__ void operator()(Acc& acc, const Unit& u, int wr, int wc, int fr, int fq) const {
        { int l_ = (int)threadIdx.x; asm volatile("" : "+v"(l_)); fr = l_ & 15; fq = (l_ >> 4) & 3; }
#pragma unroll
        for (int ai = 0; ai < 2; ++ai)
#pragma unroll
            for (int m = 0; m < 4; ++m) { bf16_t* rp = O + (size_t)(u.pm * BM + ai * HALF + wr * 64 + m * 16 + fr) * ldc + u.pn * HALF + wc * 32 + 8 * fq;
                f32x4 o[2];
#pragma unroll
                for (int n = 0; n < 2; ++n) { const f32x4 a = acc[ai][0][m][n], b = acc[ai][1][m][n]; o[n] = SILU_A ? (a * sigmoid4(a)) * b : a * sigmoid4(b); }
                *(u32x4*)rp = pack8(o[0], o[1]); }
    }
};
struct EpiMerge {
    static constexpr bool PERM = true, AFTER_DRAIN = false;
    const bf16_t *G0, *G1; bf16_t* O;
    __device__ __forceinline__ void operator()(Acc& acc, const Unit& u, int wr, int wc, int fr, int fq) const {
        { int l_ = (int)threadIdx.x; asm volatile("" : "+v"(l_)); fr = l_ & 15; fq = (l_ >> 4) & 3; }
#pragma unroll
        for (int ai = 0; ai < 2; ++ai)
#pragma unroll
            for (int m = 0; m < 4; ++m) { const size_t off = (size_t)(u.pm * BM + ai * HALF + wr * 64 + m * 16 + fr) * 1024 + u.pn * BM + wc * 32 + 8 * fq;
#pragma unroll
                for (int bj = 0; bj < 2; ++bj) {
                    f32x4 g1a, g1b; unpack8(*(const u32x4*)(G1 + off + bj * HALF), g1a, g1b);
                    if (u.kind == 0) { f32x4 g0a, g0b; unpack8(*(const u32x4*)(G0 + off + bj * HALF), g0a, g0b);
#pragma unroll
                        for (int j = 0; j < 4; ++j) { acc[ai][bj][m][0][j] *= g0a[j] * __builtin_amdgcn_rcpf(g1a[j]); acc[ai][bj][m][1][j] *= g0b[j] * __builtin_amdgcn_rcpf(g1b[j]); }
                    } else { *(u32x4*)(O + off + bj * HALF) = pack8(acc[ai][bj][m][0] * g1a, acc[ai][bj][m][1] * g1b); } } }
    }
};
struct EpiRes {
    static constexpr bool PERM = false, AFTER_DRAIN = false;
    const float* base; float* out; float alpha;
    __device__ __forceinline__ void operator()(Acc& acc, const Unit& u, int wr, int wc, int fr, int fq) const {
        { int l_ = (int)threadIdx.x; asm volatile("" : "+v"(l_)); fr = l_ & 15; fq = (l_ >> 4) & 3; }
#pragma unroll
        for (int ai = 0; ai < 2; ++ai)
#pragma unroll
            for (int m = 0; m < 4; ++m) { const size_t off = (size_t)(u.pm * BM + ai * HALF + wr * 64 + m * 16 + fr) * 1024 + u.pn * BM + wc * 32 + 4 * fq;
#pragma unroll
                for (int bj = 0; bj < 2; ++bj)
#pragma unroll
                    for (int n = 0; n < 2; ++n) { const f32x4 bs = *(const f32x4*)(base + off + bj * HALF + n * 16); *(f32x4*)(out + off + bj * HALF + n * 16) = bs * alpha + acc[ai][bj][m][n]; } }
    }
};

template <class Epi, class Sched, bool ALIGN_EPI>
__device__ __forceinline__ void gemm_phase(PG8_LAS unsigned char* lds, const Gemm g, const Sched& S, const Epi& E) {
    int tid_ = threadIdx.x; asm volatile("" : "+v"(tid_));
    const int tid = tid_, wid = __builtin_amdgcn_readfirstlane(tid >> 6), lane = tid & 63, wr = wid >> 2, wc = wid & 3, fr = lane & 15, fq = lane >> 4;
    const int nt = g.K / BK;
    unsigned voffA[2], voffB[2];
#pragma unroll
    for (int i = 0; i < 2; ++i) { int R, C; stage_rc(tid * 16 + i * 8192, R, C); const int Rb = Epi::PERM ? ((R & ~31) + perm32(R & 31)) : R;
        voffA[i] = (unsigned)(R * g.lda + C) * 2u; voffB[i] = (unsigned)(Rb * g.ldb + C) * 2u; }
    const size_t kstep = (size_t)(BK * 2);
    const size_t hstepA = (size_t)HALF * g.lda * 2, hstepB = (size_t)HALF * g.ldb * 2;
    const unsigned ldsw = (unsigned)wid * 1024u;
    const int aoff = lds_byte(wr * 64 + fr, fq * 8), boff = lds_byte(wc * 32 + fr, fq * 8);
#define PG8_SA(b, h) (((b) * 2 + (h)) * HTB)
#define PG8_SB(b, h) ((4 + (b) * 2 + (h)) * HTB)
#define PG8_STAGE(bufoff, gbase, voff) do { _Pragma("unroll") for (int _i = 0; _i < 2; ++_i) \
        __builtin_amdgcn_global_load_lds((const unsigned*)((const char*)(gbase) + (voff)[_i]), (PG8_LAS unsigned*)(lds + (bufoff) + ldsw + _i * 8192), 16, 0, 0); } while (0)
#define PG8_LDA(dst, b, h) do { _Pragma("unroll") for (int m = 0; m < 4; ++m) _Pragma("unroll") for (int k = 0; k < 2; ++k) dst[m][k] = *(const PG8_LAS bf16x8*)(lds + PG8_SA(b, h) + aoff + m * 2048 + k * 1024); } while (0)
#define PG8_LDB(dst, b, h) do { _Pragma("unroll") for (int n = 0; n < 2; ++n) _Pragma("unroll") for (int k = 0; k < 2; ++k) dst[n][k] = *(const PG8_LAS bf16x8*)(lds + PG8_SB(b, h) + boff + n * 2048 + k * 1024); } while (0)
#define PG8_MMA(ai, bj, At, Bt) do { __builtin_amdgcn_s_setprio(1); _Pragma("unroll") for (int m = 0; m < 4; ++m) _Pragma("unroll") for (int n = 0; n < 2; ++n) _Pragma("unroll") for (int k = 0; k < 2; ++k) \
        acc[ai][bj][m][n] = __builtin_amdgcn_mfma_f32_16x16x32_bf16(Bt[n][k], At[m][k], acc[ai][bj][m][n], 0, 0, 0); __builtin_amdgcn_s_setprio(0); } while (0)
#define PG8_WAIT_V(n) asm volatile("s_waitcnt vmcnt(" #n ")" ::: "memory")
#define PG8_WAIT_L(n) asm volatile("s_waitcnt lgkmcnt(" #n ")" ::: "memory")
#define PG8_BAR __builtin_amdgcn_s_barrier()
#define PG8_SCHED __builtin_amdgcn_sched_barrier(0)
#define PG8_ZERO() do { _Pragma("unroll") for (int a_ = 0; a_ < 2; ++a_) _Pragma("unroll") for (int b_ = 0; b_ < 2; ++b_) _Pragma("unroll") for (int m_ = 0; m_ < 4; ++m_) _Pragma("unroll") for (int n_ = 0; n_ < 2; ++n_) acc[a_][b_][m_][n_] = (f32x4){0.f, 0.f, 0.f, 0.f}; } while (0)
    Unit cur, nxt; int ui = 0;
    if (!S.next(0, cur)) return;
    Acc acc;
    PG8_ZERO();
    bf16x8 At[4][2], B0[2][2], B1[2][2];
    const char* cA = cur.a; const char* cB = cur.b;
    PG8_STAGE(PG8_SB(0, 0), cB, voffB); PG8_STAGE(PG8_SB(0, 1), cB + hstepB, voffB); PG8_STAGE(PG8_SA(0, 0), cA, voffA); PG8_STAGE(PG8_SA(0, 1), cA + hstepA, voffA);
    if (wr == 1) PG8_BAR;
    PG8_WAIT_V(2); PG8_BAR;
    PG8_STAGE(PG8_SB(1, 0), cB + kstep, voffB); PG8_STAGE(PG8_SA(1, 0), cA + kstep, voffA); PG8_STAGE(PG8_SB(1, 1), cB + hstepB + kstep, voffB);
    PG8_WAIT_V(6); PG8_BAR;
    for (;;) {
        const bool has_next = S.next(ui + 1, nxt);
        const char* nA = has_next ? nxt.a : cA; const char* nB = has_next ? nxt.b : cB;
#pragma unroll 1
        for (int t = 0; t < nt; t += 2) {
            const bool last = (t == nt - 2);
            const char* a1 = cA + (size_t)(t + 1) * kstep;
            const char* a2 = last ? nA : cA + (size_t)(t + 2) * kstep; const char* b2 = last ? nB : cB + (size_t)(t + 2) * kstep;
            const char* a3 = a2 + kstep; const char* b3 = b2 + kstep;
            PG8_LDB(B0, 0, 0); PG8_LDB(B1, 0, 1); PG8_SCHED; PG8_LDA(At, 0, 0); PG8_STAGE(PG8_SA(1, 1), a1 + hstepA, voffA);
            PG8_WAIT_V(8); PG8_WAIT_L(0); PG8_BAR; PG8_MMA(0, 0, At, B0); PG8_MMA(0, 1, At, B1); PG8_BAR; PG8_SCHED;
            PG8_LDA(At, 0, 1); PG8_STAGE(PG8_SB(0, 0), b2, voffB); PG8_STAGE(PG8_SB(0, 1), b2 + hstepB, voffB); PG8_STAGE(PG8_SA(0, 0), a2, voffA);
            PG8_WAIT_V(8); PG8_WAIT_L(0); PG8_BAR; PG8_MMA(1, 0, At, B0); PG8_MMA(1, 1, At, B1); PG8_BAR; PG8_SCHED;
            PG8_LDB(B0, 1, 0); PG8_LDB(B1, 1, 1); PG8_SCHED; PG8_LDA(At, 1, 0); PG8_STAGE(PG8_SA(0, 1), a2 + hstepA, voffA);
            PG8_WAIT_V(8); PG8_WAIT_L(0); PG8_BAR; PG8_MMA(0, 0, At, B0); PG8_MMA(0, 1, At, B1); PG8_BAR; PG8_SCHED;
            PG8_LDA(At, 1, 1); PG8_STAGE(PG8_SB(1, 0), b3, voffB); PG8_STAGE(PG8_SB(1, 1), b3 + hstepB, voffB); PG8_STAGE(PG8_SA(1, 0), a3, voffA);
            PG8_WAIT_V(8); PG8_WAIT_L(0); PG8_BAR; PG8_MMA(1, 0, At, B0); PG8_MMA(1, 1, At, B1); PG8_BAR; PG8_SCHED;
        }
        if constexpr (ALIGN_EPI) { if (wr == 0) PG8_BAR; }
        E(acc, cur, wr, wc, fr, fq);
        if (!has_next) break;
        if (!nxt.keep) PG8_ZERO();
        cur = nxt; cA = nA; cB = nB; ++ui;
        if constexpr (ALIGN_EPI) { if (wr == 1) PG8_BAR; }
    }
    PG8_WAIT_V(0);
    if constexpr (!ALIGN_EPI) { if (wr == 0) PG8_BAR; }
    PG8_BAR;
#undef PG8_SA
#undef PG8_SB
#undef PG8_STAGE
#undef PG8_LDA
#undef PG8_LDB
#undef PG8_MMA
#undef PG8_WAIT_V
#undef PG8_WAIT_L
#undef PG8_BAR
#undef PG8_SCHED
#undef PG8_ZERO
}
}

#include <hip/hip_bf16.h>
#include <cmath>
namespace attn_body {
using bf16=__hip_bfloat16;
using bf16x8=__attribute__((ext_vector_type(8)))short;
using s16x4=__attribute__((ext_vector_type(4)))short;
using f32x16=__attribute__((ext_vector_type(16)))float;
using u32x4=__attribute__((ext_vector_type(4)))unsigned;
constexpr int SEQ=4096,D=64,QP=512,OP=1024;
constexpr int NW=8,QBLK=32,QB=QBLK*NW,KVBLK=64,NQB=SEQ/QB;
constexpr int ATTN_UNIT_ROWS=QB;
__device__ __forceinline__ int crow(int r,int hi){return (r&3)+8*(r>>2)+4*hi;}
#define SBAR() __builtin_amdgcn_sched_barrier(0)
__device__ __forceinline__ void cmask(f32x16&p0,f32x16&p1,int jb,int qrel,int hi){
  const float NEG=-INFINITY; int kb=64*jb+4*hi;
  #pragma unroll
  for(int r=0;r<16;++r){int kv=kb+(r&3)+8*(r>>2); if(kv>qrel)p0[r]=NEG; if(kv+32>qrel)p1[r]=NEG;}
}

constexpr int NSLOT=3, SLOTB=8192;
constexpr int LDS_K=0, LDS_V=NSLOT*SLOTB, LDS_WS=2*NSLOT*SLOTB, LDS_OST=LDS_WS+NW*64*4, LDS_BYTES=LDS_OST+NW*4096;
constexpr float C2=0.125f*1.4426950408889634f;
__device__ __forceinline__ void glds16(const void*gsrc,unsigned lds_dst){unsigned keep;
  asm volatile("s_mov_b32 %0, m0\n\ts_mov_b32 m0, %2\n\ts_nop 0\n\tglobal_load_lds_dwordx4 %1, off\n\ts_mov_b32 m0, %0":"=&s"(keep):"v"(gsrc),"s"(lds_dst):"memory");}
__device__ __forceinline__ float max3f(float a,float b,float c){float r;asm("v_max3_f32 %0, %1, %2, %3":"=v"(r):"v"(a),"v"(b),"v"(c));return r;}
__device__ __forceinline__ float max2f(float a,float b){float r;asm("v_max_f32_e32 %0, %1, %2":"=v"(r):"v"(a),"v"(b));return r;}
__device__ __forceinline__ float fadd_s(float a,float b){float r;asm("v_add_f32_e32 %0, %1, %2":"=v"(r):"v"(a),"v"(b));return r;}
__device__ __forceinline__ float fsub_s(float a,float b){float r;asm("v_sub_f32_e32 %0, %1, %2":"=v"(r):"v"(a),"v"(b));return r;}
typedef float f32x2_t __attribute__((ext_vector_type(2))); typedef __bf16 bf16x2_t __attribute__((ext_vector_type(2)));
__device__ __forceinline__ unsigned cvtpk_s(float lo,float hi){f32x2_t v={lo,hi};bf16x2_t b=__builtin_convertvector(v,bf16x2_t);return __builtin_bit_cast(unsigned,b);}
#define WAIT_BAR(N) asm volatile("s_waitcnt vmcnt(" #N ") lgkmcnt(0)\n\ts_barrier":::"memory")

__device__ __forceinline__ void qkt(f32x16&p0,f32x16&p1,const char*Kslot,const bf16x8*qr,const f32x16&negm,int r32,int hi){
  const char*kb=Kslot+hi*1024+r32*16;
  #pragma unroll
  for(int d0=0;d0<4;++d0){
    const bf16x8 b0=*reinterpret_cast<const bf16x8*>(kb+d0*2048);
    const bf16x8 b1=*reinterpret_cast<const bf16x8*>(kb+d0*2048+512);
    if(d0==0){p0=__builtin_amdgcn_mfma_f32_32x32x16_bf16(b0,qr[0],negm,0,0,0);p1=__builtin_amdgcn_mfma_f32_32x32x16_bf16(b1,qr[0],negm,0,0,0);}
    else{p0=__builtin_amdgcn_mfma_f32_32x32x16_bf16(b0,qr[d0],p0,0,0,0);p1=__builtin_amdgcn_mfma_f32_32x32x16_bf16(b1,qr[d0],p1,0,0,0);}}
}
typedef __attribute__((address_space(3))) const char* lds_cptr;
typedef short v4i16_t __attribute__((ext_vector_type(4)));
__device__ __forceinline__ void kload8(bf16x8*kf,lds_cptr kp){
  kf[0]=*(const __attribute__((address_space(3))) bf16x8*)(kp);      kf[1]=*(const __attribute__((address_space(3))) bf16x8*)(kp+512);
  kf[2]=*(const __attribute__((address_space(3))) bf16x8*)(kp+2048); kf[3]=*(const __attribute__((address_space(3))) bf16x8*)(kp+2560);
  kf[4]=*(const __attribute__((address_space(3))) bf16x8*)(kp+4096); kf[5]=*(const __attribute__((address_space(3))) bf16x8*)(kp+4608);
  kf[6]=*(const __attribute__((address_space(3))) bf16x8*)(kp+6144); kf[7]=*(const __attribute__((address_space(3))) bf16x8*)(kp+6656);
}
__device__ __forceinline__ void kload2(bf16x8*kf,lds_cptr kp,int j){ kf[2*j]=*(const __attribute__((address_space(3))) bf16x8*)(kp+j*2048); kf[2*j+1]=*(const __attribute__((address_space(3))) bf16x8*)(kp+j*2048+512); }
__device__ __forceinline__ s16x4 vtr(lds_cptr p){ return __builtin_bit_cast(s16x4,__builtin_amdgcn_ds_read_tr16_b64_v4i16((__attribute__((address_space(3))) v4i16_t*)p)); }
__device__ __forceinline__ float rowmax(const f32x16&p0,const f32x16&p1){
  float a=max3f(p0[0],p0[1],p1[0]),b=max3f(p0[2],p0[3],p1[1]);a=max3f(a,p1[2],p1[3]);
  #pragma unroll
  for(int r=4;r<16;r+=4){a=max3f(a,p0[r],p0[r+1]);b=max3f(b,p0[r+2],p0[r+3]);a=max3f(a,p1[r],p1[r+1]);b=max3f(b,p1[r+2],p1[r+3]);}
  const float m=max2f(a,b);
  auto rr=__builtin_amdgcn_permlane32_swap(__float_as_uint(m),__float_as_uint(m),false,false);
  return max2f(__uint_as_float(rr[0]),__uint_as_float(rr[1]));
}
__device__ __forceinline__ void pv(f32x16*o,int vb,bf16x8 pa0,bf16x8 pa1,bf16x8 pa2,bf16x8 pa3){
  #pragma unroll
  for(int d0=0;d0<2;++d0){s16x4 lo[4],hi[4];
    #pragma unroll
    for(int ks=0;ks<4;++ks){
      asm volatile("ds_read_b64_tr_b16 %0,%1 offset:%c2":"=&v"(lo[ks]):"v"(vb),"i"(d0*4096+ks*1024):"memory");
      asm volatile("ds_read_b64_tr_b16 %0,%1 offset:%c2":"=&v"(hi[ks]):"v"(vb),"i"(d0*4096+ks*1024+512):"memory");}
    asm volatile("s_waitcnt lgkmcnt(0)":::"memory");SBAR();
    #define PK(k) (bf16x8){lo[k][0],lo[k][1],lo[k][2],lo[k][3],hi[k][0],hi[k][1],hi[k][2],hi[k][3]}
    o[d0]=__builtin_amdgcn_mfma_f32_32x32x16_bf16(pa0,PK(0),o[d0],0,0,0);
    o[d0]=__builtin_amdgcn_mfma_f32_32x32x16_bf16(pa1,PK(1),o[d0],0,0,0);
    o[d0]=__builtin_amdgcn_mfma_f32_32x32x16_bf16(pa2,PK(2),o[d0],0,0,0);
    o[d0]=__builtin_amdgcn_mfma_f32_32x32x16_bf16(pa3,PK(3),o[d0],0,0,0);
    #undef PK
  }
}

#ifndef ATTN_STORE16
#define ATTN_STORE16(p,v) (*(u32x4*)(p)=(v))
#endif
template<int THRL> __device__ __forceinline__ void attn_unit(int b,int qcol,int vcol,int ocol,int qb,const bf16*Q,const bf16*__restrict__ K,const bf16*__restrict__ V,bf16*O,char*shm){
  int tid_l=threadIdx.x; asm volatile("":"+v"(tid_l));   const int tid=tid_l,lane=tid&63,r32=lane&31,hi=lane>>5; const int wid=__builtin_amdgcn_readfirstlane(tid>>6);
  const long rowbase=(long)b*SEQ; const int q0=qb*QB;
  const bf16*Qw=Q+(rowbase+q0+wid*QBLK)*QP+qcol;
  const bf16*Kh=K+rowbase*QP+qcol,*Vh=V+rowbase*QP+vcol;
  const unsigned lds0=(unsigned)(uintptr_t)shm;
  float*wsf=(float*)(shm+LDS_WS)+wid*64;
  const bf16*ksrc=Kh+(long)lane*QP+wid*8;
  const bf16*vsrc=Vh+(long)(16*(wid&3)+(lane>>2))*QP+(wid>>2)*32+(lane&3)*8;
  const unsigned kdst=lds0+LDS_K+wid*1024, vdst=lds0+LDS_V+wid*1024;
  #define DMA_K(t,slot) glds16(ksrc+(long)(t)*KVBLK*QP,(unsigned)__builtin_amdgcn_readfirstlane(kdst+(slot)))
  #define DMA_V(t,slot) glds16(vsrc+(long)(t)*KVBLK*QP,(unsigned)__builtin_amdgcn_readfirstlane(vdst+(slot)))
  const int vb0=(int)(lds0+LDS_V)+((lane>>4)&1)*32+(lane&3)*8+(4*hi+((lane&15)>>2))*64;
  const char*Kbase=shm+LDS_K; bf16x8 kf[8];
  const lds_cptr shm3=(lds_cptr)shm; const lds_cptr kp0=shm3+LDS_K+hi*1024+r32*16; const lds_cptr vp0=shm3+LDS_V+((lane>>4)&1)*32+(lane&3)*8+(4*hi+((lane&15)>>2))*64;
  const int NT=(q0+QB)/KVBLK;
  DMA_K(0,0);DMA_V(0,0);DMA_K(1,SLOTB);
  bf16x8 qr[4];
  #pragma unroll
  for(int d0=0;d0<4;++d0)qr[d0]=*reinterpret_cast<const bf16x8*>(&Qw[(long)r32*QP+d0*16+hi*8]);
  float mhat=0.f,l_reg=0.f;f32x16 o[2];o[0]=f32x16{};o[1]=f32x16{};f32x16 negm=f32x16{};asm volatile("":"+v"(negm));
  const int qrel=wid*QBLK+r32;
  #define CMASK(P0,P1,t) do{int jb_=(t)-(NT-4); if(jb_>=0)cmask(P0,P1,jb_,qrel,hi);}while(0)
  bool resc=false;
  #define START(P0,P1) do{ const float rm=rowmax(P0,P1); resc=false; \
    { const float dl=rm; mhat=fadd_s(mhat,dl); \
      _Pragma("unroll") for(int r=0;r<16;++r){P0[r]=fsub_s(P0[r],dl);P1[r]=fsub_s(P1[r],dl);} \
      _Pragma("unroll") for(int r=0;r<16;++r)negm[r]=-mhat; asm volatile("":"+v"(negm)); } \
    _Pragma("unroll") for(int r=0;r<16;++r)P0[r]=__builtin_amdgcn_exp2f(P0[r]); }while(0)
  #define RESC() do{ if(resc){ asm volatile("s_waitcnt lgkmcnt(0)":::"memory"); \
      _Pragma("unroll") for(int d_=0;d_<2;++d_) _Pragma("unroll") for(int r=0;r<16;++r)o[d_][r]*=wsf[crow(r,hi)]; } }while(0)
  f32x16 pA0,pA1,pB0,pB1;
  int sl_prev=0,sl_cur=0,sl_next=SLOTB;
  #define ROT() do{sl_prev=sl_cur;sl_cur=sl_next;sl_next=(sl_next==(NSLOT-1)*SLOTB)?0:sl_next+SLOTB;}while(0)
  DMA_K(2,2*SLOTB);
  WAIT_BAR(3);
  qkt(pA0,pA1,Kbase,qr,negm,r32,hi);asm volatile("s_nop 15\n\ts_nop 7":"+v"(pA0),"+v"(pA1));CMASK(pA0,pA1,0);
  START(pA0,pA1);
  _Pragma("unroll") for(int r=0;r<16;++r)pA1[r]=__builtin_amdgcn_exp2f(pA1[r]);
  WAIT_BAR(0);
  DMA_K(3,0);DMA_V(1,SLOTB);
  ROT();
  kload8(kf,kp0+sl_cur);
  WAIT_BAR(2);
  s16x4 vlo[8],vhi[8]; u32x4 pw0,pw1,pw2,pw3;
  #define PKW(P,B) cvtpk_s(P[B],P[B+1])
  #define PAF(k) __builtin_bit_cast(bf16x8,pw##k)
  #define VFR(i) (bf16x8){vlo[i][0],vlo[i][1],vlo[i][2],vlo[i][3],vhi[i][0],vhi[i][1],vhi[i][2],vhi[i][3]}
  #define PIN(x) asm volatile("":"+v"(x))
  #define MX3(a,b,c) __builtin_fmaxf(__builtin_fmaxf((a),(b)),(c))
  #define GAPA(MF,A0,A1,A2,A3,W0,W1,PW) do{ MF; sacc+=A0; sacc+=A1; sacc+=A2; sacc+=A3; PIN(sacc); W0; W1; PIN(PW); SBAR(); }while(0)
  #define EX(v) __builtin_amdgcn_exp2f(v)
  #define GAPB(MF,X,B) do{ MF; X[B]=EX(X[B]); X[B+1]=EX(X[B+1]); X[B+2]=EX(X[B+2]); X[B+3]=EX(X[B+3]); PIN(X); SBAR(); }while(0)
  #define VRD(i) do{ vlo[i]=vtr(vp_+(((i)>>2)*4096+((i)&3)*1024)); vhi[i]=vtr(vp_+(((i)>>2)*4096+((i)&3)*1024+512)); }while(0)
  #define KRD(G,j) do{ if(G){ kload2(kf,kp0+sl_next,j); SBAR(); } }while(0)
  #define STEP(C0,C1,P0,P1,t,GK,GV,GL) do{ SBAR(); \
    const lds_cptr vp_=vp0+sl_prev; \
    VRD(0); SBAR(); float sacc=(P0[0]+P0[1]); \
    GAPA(C0=__builtin_amdgcn_mfma_f32_32x32x16_bf16(kf[0],qr[0],negm,0,0,0), P0[2],P0[3],P0[4],P0[5],     pw0[0]=PKW(P0,0), pw0[1]=PKW(P0,2), pw0); \
    VRD(4); SBAR(); GAPA(C1=__builtin_amdgcn_mfma_f32_32x32x16_bf16(kf[1],qr[0],negm,0,0,0), P0[6],P0[7],P0[8],P0[9],     pw0[2]=PKW(P0,4), pw0[3]=PKW(P0,6), pw0); \
    VRD(1); SBAR(); GAPA(C0=__builtin_amdgcn_mfma_f32_32x32x16_bf16(kf[2],qr[1],C0,0,0,0),   P0[10],P0[11],P0[12],P0[13], pw1[0]=PKW(P0,8), pw1[1]=PKW(P0,10), pw1); \
    VRD(5); SBAR(); GAPA(C1=__builtin_amdgcn_mfma_f32_32x32x16_bf16(kf[3],qr[1],C1,0,0,0),   P0[14],P0[15],P1[0],P1[1],   pw1[2]=PKW(P0,12),pw1[3]=PKW(P0,14), pw1); \
    VRD(2); SBAR(); GAPA(C0=__builtin_amdgcn_mfma_f32_32x32x16_bf16(kf[4],qr[2],C0,0,0,0),   P1[2],P1[3],P1[4],P1[5],     pw2[0]=PKW(P1,0), pw2[1]=PKW(P1,2), pw2); \
    VRD(6); SBAR(); GAPA(C1=__builtin_amdgcn_mfma_f32_32x32x16_bf16(kf[5],qr[2],C1,0,0,0),   P1[6],P1[7],P1[8],P1[9],     pw2[2]=PKW(P1,4), pw2[3]=PKW(P1,6), pw2); \
    VRD(3); SBAR(); GAPA(C0=__builtin_amdgcn_mfma_f32_32x32x16_bf16(kf[6],qr[3],C0,0,0,0),   P1[10],P1[11],P1[12],P1[13], pw3[0]=PKW(P1,8), pw3[1]=PKW(P1,10), pw3); \
    VRD(7); SBAR(); GAPA(C1=__builtin_amdgcn_mfma_f32_32x32x16_bf16(kf[7],qr[3],C1,0,0,0),   P1[14],P1[15],0.f,0.f,       pw3[2]=PKW(P1,12),pw3[3]=PKW(P1,14), pw3); \
    l_reg+=sacc; \
    if(GK){DMA_K((t)+3,sl_cur);} if(GV){DMA_V((t)+1,sl_next);} \
    CMASK(C0,C1,t); \
    { float a=MX3(C0[0],C0[1],C1[0]),b=MX3(C0[2],C0[3],C1[1]); a=MX3(a,C1[2],C1[3]); \
      _Pragma("unroll") for(int r=4;r<16;r+=4){a=MX3(a,C0[r],C0[r+1]);b=MX3(b,C0[r+2],C0[r+3]);a=MX3(a,C1[r],C1[r+1]);b=MX3(b,C1[r+2],C1[r+3]);} \
      float rm=__builtin_fmaxf(a,b); { auto rr=__builtin_amdgcn_permlane32_swap(__float_as_uint(rm),__float_as_uint(rm),false,false); rm=__builtin_fmaxf(__uint_as_float(rr[0]),__uint_as_float(rr[1])); } \
      resc=false; \
      if(__builtin_expect(__any(rm>(float)THRL),0)){ const float dl=__builtin_fmaxf(rm,0.f); mhat+=dl; \
        _Pragma("unroll") for(int r=0;r<16;++r){C0[r]-=dl;C1[r]-=dl;} \
        _Pragma("unroll") for(int r=0;r<16;++r)negm[r]=-mhat; asm volatile("":"+v"(negm)); \
        const float f=__builtin_amdgcn_exp2f(-dl); l_reg*=f; if(hi==0)wsf[r32]=f; resc=true; } } \
    SBAR(); \
    GAPB(o[0]=__builtin_amdgcn_mfma_f32_32x32x16_bf16(PAF(0),VFR(0),o[0],0,0,0), C0,0); \
    GAPB(o[1]=__builtin_amdgcn_mfma_f32_32x32x16_bf16(PAF(0),VFR(4),o[1],0,0,0), C0,4); \
    KRD(GL,0); GAPB(o[0]=__builtin_amdgcn_mfma_f32_32x32x16_bf16(PAF(1),VFR(1),o[0],0,0,0), C0,8); \
    KRD(GL,1); GAPB(o[1]=__builtin_amdgcn_mfma_f32_32x32x16_bf16(PAF(1),VFR(5),o[1],0,0,0), C0,12); \
    KRD(GL,2); GAPB(o[0]=__builtin_amdgcn_mfma_f32_32x32x16_bf16(PAF(2),VFR(2),o[0],0,0,0), C1,0); \
    KRD(GL,3); GAPB(o[1]=__builtin_amdgcn_mfma_f32_32x32x16_bf16(PAF(2),VFR(6),o[1],0,0,0), C1,4); \
    GAPB(o[0]=__builtin_amdgcn_mfma_f32_32x32x16_bf16(PAF(3),VFR(3),o[0],0,0,0), C1,8); \
    GAPB(o[1]=__builtin_amdgcn_mfma_f32_32x32x16_bf16(PAF(3),VFR(7),o[1],0,0,0), C1,12); \
    }while(0)
  int t=1;
  #undef CMASK
  #define CMASK(P0,P1,t) do{}while(0)
  for(;t+5<NT;t+=2){
    STEP(pB0,pB1,pA0,pA1,t,true,true,true);     WAIT_BAR(2); RESC(); ROT();
    STEP(pA0,pA1,pB0,pB1,t+1,true,true,true);   WAIT_BAR(2); RESC(); ROT();
  }
  #undef CMASK
  #define CMASK(P0,P1,t) do{int jb_=(t)-(NT-4); if(jb_>=0)cmask(P0,P1,jb_,qrel,hi);}while(0)
  #define ENDW(tt) do{ if((tt)+3<NT){WAIT_BAR(2);} else if((tt)+2<NT){WAIT_BAR(1);} else {WAIT_BAR(0);} }while(0)
  for(;t+1<NT;t+=2){
    STEP(pB0,pB1,pA0,pA1,t,(t+3<NT),(t+1<NT),(t+1<NT));       ENDW(t);   RESC(); ROT();
    STEP(pA0,pA1,pB0,pB1,t+1,(t+4<NT),(t+2<NT),(t+2<NT));     ENDW(t+1); RESC(); ROT();
  }
  STEP(pB0,pB1,pA0,pA1,NT-1,false,false,false); RESC();
  { float sacc=pB0[0]+pB0[1]; _Pragma("unroll") for(int r=2;r<16;++r)sacc+=pB0[r]; _Pragma("unroll") for(int r=0;r<16;++r)sacc+=pB1[r]; l_reg+=sacc;
    pw0=(u32x4){PKW(pB0,0),PKW(pB0,2),PKW(pB0,4),PKW(pB0,6)};pw1=(u32x4){PKW(pB0,8),PKW(pB0,10),PKW(pB0,12),PKW(pB0,14)};pw2=(u32x4){PKW(pB1,0),PKW(pB1,2),PKW(pB1,4),PKW(pB1,6)};pw3=(u32x4){PKW(pB1,8),PKW(pB1,10),PKW(pB1,12),PKW(pB1,14)};
    SBAR(); pv(o,vb0+sl_cur,PAF(0),PAF(1),PAF(2),PAF(3)); }
  #undef PKW
  #undef PAF
  #undef VFR
  #undef PIN
  #undef MX3
  #undef GAPA
  #undef GAPB
  #undef EX
  #undef VRD
  #undef KRD
  #undef STEP
  #undef ENDW
  {auto rr=__builtin_amdgcn_permlane32_swap(__float_as_uint(l_reg),__float_as_uint(l_reg),false,false);l_reg=__uint_as_float(rr[0])+__uint_as_float(rr[1]);}
  if(hi==0)wsf[32+r32]=l_reg;asm volatile("s_waitcnt lgkmcnt(0)":::"memory");
  float rli[16];
  #pragma unroll
  for(int r=0;r<16;++r)rli[r]=__builtin_amdgcn_rcpf(wsf[32+crow(r,hi)]);
  bf16*Ow=O+(rowbase+q0+wid*QBLK)*OP+ocol;
  { bf16*stg=(bf16*)(shm+LDS_OST)+wid*2048;
    #pragma unroll
    for(int r=0;r<16;++r){const int orow=crow(r,hi);
      #pragma unroll
      for(int d0=0;d0<2;++d0)stg[orow*64+d0*32+r32]=__float2bfloat16(o[d0][r]*rli[r]);}
    asm volatile("s_waitcnt lgkmcnt(0)":::"memory");
    #pragma unroll
    for(int i=0;i<4;++i){const int row=i*8+(lane>>3),ch=lane&7; const u32x4 v=*(const u32x4*)(stg+row*64+ch*8); ATTN_STORE16(Ow+(long)row*OP+ch*8,v);} }
  asm volatile("s_waitcnt lgkmcnt(0)\n\ts_barrier":::"memory");
  #undef DMA_K
  #undef DMA_V
  #undef CMASK
  #undef START
  #undef RESC
  #undef ROT
}
constexpr int ATTN_LDS_BYTES=LDS_BYTES;
#undef SBAR
#undef WAIT_BAR
}

constexpr int NWAVES = 8;
constexpr int BATCH = 8, SEQ = 4096, DMOD = 1024, M = BATCH * SEQ, DIN = 4096, DFF = 2816;
constexpr float LN_EPS = 1e-5f, RMS_EPS = 1e-5f, ALPHA = 1.189207115002721f, LAMBDA_INIT = 0.2f;
constexpr float QSCALE = 0.125f * 1.4426950408889634f;
constexpr size_t MiB = 1u << 20;
constexpr size_t WS_CTL = 0, CTL_BYTES = 16384;
constexpr size_t WS_WIN = 1 * MiB, WS_WGLU = 9 * MiB, WS_WP = 10 * MiB, WS_WOUT = 12 * MiB, WS_WGU = 14 * MiB, WS_WD = 25 * MiB, WS_TP = 31 * MiB, WS_BS = 37 * MiB, WS_ROPE = 41 * MiB, WS_A16 = 42 * MiB;
constexpr size_t WS_XB = 48 * MiB, WS_CAT = 48 * MiB, WS_ACT = 48 * MiB, WS_G0 = 112 * MiB, WS_G1 = 176 * MiB, WS_Q = 240 * MiB, WS_K = 272 * MiB, WS_V = 304 * MiB, WS_AP = 336 * MiB, WS_I = 384 * MiB,
                 WS_YG = 416 * MiB, WS_O = 448 * MiB, WS_MRG = 240 * MiB, WS_X1 = 304 * MiB, WS_X1B = 432 * MiB, WS_END = 512 * MiB;
constexpr int RING_BYTES = 131072, LDS_BYTES = 147456;

#define GAS __attribute__((address_space(1)))
#define LAS __attribute__((address_space(3)))
typedef unsigned short bf16;
typedef unsigned v4u __attribute__((ext_vector_type(4)));
typedef float f32x4 __attribute__((ext_vector_type(4)));
#define LDS_WAIT() asm volatile("s_waitcnt lgkmcnt(0)" ::: "memory")
__device__ __forceinline__ unsigned f2bf(float f) { unsigned u = __builtin_bit_cast(unsigned, f); return (u + 0x7fffu + ((u >> 16) & 1u)) >> 16; }
__device__ __forceinline__ unsigned pk2(float lo, float hi) { return f2bf(lo) | (f2bf(hi) << 16); }
__device__ __forceinline__ float wave_sum(float v) {
#pragma unroll
    for (int o = 1; o < 64; o <<= 1) v += __shfl_xor(v, o);
    return v;
}

#define RLX_AGENT __ATOMIC_RELAXED, __HIP_MEMORY_SCOPE_AGENT
#define XB_TMO      128
#define XB_XCNT(j)  (256  + 64 * (j))
#define XB_XSUB(j)  (1280 + 64 * (j))
#define XB_XGEN(j)  (2304 + 64 * (j))
#define XB_TOP      3328
#define XB_TOPGEN   3392
#define XCD_BAR_WORDS 3456
#define XB_SPIN_CAP (1u << 18)

__device__ __forceinline__ unsigned xb_ld(unsigned* p)              { return __hip_atomic_load(p, __ATOMIC_RELAXED, __HIP_MEMORY_SCOPE_AGENT); }
__device__ __forceinline__ unsigned xb_add(unsigned* p, unsigned v) { return __hip_atomic_fetch_add(p, v, __ATOMIC_RELAXED, __HIP_MEMORY_SCOPE_AGENT); }
__device__ __forceinline__ unsigned xb_xcc_id() { return (unsigned)__builtin_amdgcn_s_getreg((3 << 11) | 20) & 0xFu; }
#define XB_SPIN(cond, bar) do { unsigned _sp = 0; while (cond) { __builtin_amdgcn_s_sleep(1); \
    if ((++_sp & 255u) == 0u) { if (xb_ld(&(bar)[XB_TMO])) break; if (_sp > XB_SPIN_CAP) { atomicAdd(&(bar)[XB_TMO], 1u); break; } } } } while (0)

struct XcdBarrier {
    unsigned* bar; unsigned x;
    volatile LAS unsigned* st;
};

__device__ __forceinline__ XcdBarrier xcd_barrier_post(unsigned* bar, volatile LAS unsigned* st) {
    XcdBarrier b; b.bar = bar; b.x = xb_xcc_id(); b.st = st;
    if (threadIdx.x == 0) (void)xb_add(&bar[XB_XCNT(b.x)], 1u);
    return b;
}
__device__ __forceinline__ void xcd_barrier_complete(unsigned* bar, unsigned x, unsigned& nloc, unsigned& nx) {
    const unsigned G = gridDim.x * gridDim.y * gridDim.z;
    unsigned sum, cnt, mine, sp = 0u;
    for (;;) {
        sum = 0u; cnt = 0u; mine = 0u;
#pragma unroll
        for (unsigned j = 0; j < 16; ++j) { const unsigned c = xb_ld(&bar[XB_XCNT(j)]); sum += c; cnt += (c > 0u) ? 1u : 0u; mine = (j == x) ? c : mine; }
        if (sum == G) break;
        __builtin_amdgcn_s_sleep(1);
        if ((++sp & 255u) == 0u) { if (xb_ld(&bar[XB_TMO])) break; if (sp > XB_SPIN_CAP) { atomicAdd(&bar[XB_TMO], 1u); break; } }
    }
    nloc = mine > 0u ? mine : 1u; nx = cnt > 0u ? cnt : 1u;
}

__device__ __forceinline__ void xcd_barrier(const XcdBarrier& b) {
    asm volatile("s_waitcnt vmcnt(0)" ::: "memory");
    __syncthreads();
    if (threadIdx.x == 0) {
        unsigned* bar = b.bar;
        __builtin_amdgcn_s_waitcnt(0);
        unsigned nloc = b.st[0], nx = b.st[1];
        if (nloc == 0u) { xcd_barrier_complete(bar, b.x, nloc, nx); b.st[0] = nloc; b.st[1] = nx; }
        const unsigned old = xb_add(&bar[XB_XSUB(b.x)], 1u);
        const unsigned gen = old / nloc;
        if (old + 1u == (gen + 1u) * nloc) {
            __builtin_amdgcn_fence(__ATOMIC_RELEASE, "agent");
            asm volatile("s_waitcnt vmcnt(0)" ::: "memory");
            const unsigned og = xb_add(&bar[XB_TOP], 1u);
            const unsigned tg = og / nx;
            if (og + 1u == (tg + 1u) * nx) xb_add(&bar[XB_TOPGEN], 1u);
            else XB_SPIN(xb_ld(&bar[XB_TOPGEN]) == tg, bar);
            __builtin_amdgcn_fence(__ATOMIC_ACQUIRE, "agent");
            xb_add(&bar[XB_XGEN(b.x)], 1u);
            asm volatile("s_waitcnt vmcnt(0)" ::: "memory");
        } else {
            XB_SPIN(xb_ld(&bar[XB_XGEN(b.x)]) == gen, bar);
            __builtin_amdgcn_fence(__ATOMIC_ACQUIRE, "agent");
            asm volatile("s_waitcnt vmcnt(0)" ::: "memory");
        }
    }
    __syncthreads();
}

struct Args { const float* in[27]; float* out; unsigned char* ws; int ph_lo, ph_hi; };

__device__ __forceinline__ int ltid() { int t = threadIdx.x; asm volatile("" : "+v"(t)); return t; }
struct Frame {
    LAS unsigned char* lds;
    int wave, vcu, G;
    const Args* a; unsigned char* ws;
};

__device__ __forceinline__ void cexpd(double zr, double zi, double& er, double& ei) {
    const double z = zr * 0.0625; double e = 1.0;
#pragma unroll
    for (int k = 14; k >= 1; --k) e = 1.0 + e * z / (double)k;
    e = e * e; e = e * e; e = e * e; e = e * e;
    double rev = zi * 0.15915494309189535; rev -= rint(rev);
    const double q = rint(rev * 4.0); const double y = (rev - q * 0.25) * 6.283185307179586;
    const double y2 = y * y;
    const double sn = y * (1.0 + y2 * (-1.0 / 6 + y2 * (1.0 / 120 + y2 * (-1.0 / 5040 + y2 * (1.0 / 362880 + y2 * (-1.0 / 39916800 + y2 * (1.0 / 6227020800.0)))))));
    const double cs = 1.0 + y2 * (-0.5 + y2 * (1.0 / 24 + y2 * (-1.0 / 720 + y2 * (1.0 / 40320 + y2 * (-1.0 / 3628800 + y2 * (1.0 / 479001600.0 + y2 * (-1.0 / 87178291200.0)))))));
    const int qi = ((int)q) & 3;
    const double c = (qi == 0) ? cs : (qi == 1) ? -sn : (qi == 2) ? -cs : sn;
    const double s = (qi == 0) ? sn : (qi == 1) ? cs : (qi == 2) ? -sn : -cs;
    er = e * c; ei = e * s;
}

__device__ __forceinline__ void p0_transpose_item(const float* W, int N, bf16* WT, int ldt, int koff, int k0, int n0, int drow0, LAS float* scr, int lane) {
#pragma unroll 8
    for (int i = 0; i < 32; ++i) { const int kk = 2 * i + (lane >> 5); scr[kk * 33 + (lane & 31)] = W[(size_t)(k0 + kk) * N + n0 + (lane & 31)]; }
    LDS_WAIT(); asm volatile("" ::: "memory");
    const int c = lane & 7;
#pragma unroll
    for (int j = 0; j < 4; ++j) { const int n = (lane >> 3) + 8 * j; const LAS float* s = scr + (8 * c) * 33 + n;
        v4u o; o.x = pk2(s[0 * 33], s[1 * 33]); o.y = pk2(s[2 * 33], s[3 * 33]); o.z = pk2(s[4 * 33], s[5 * 33]); o.w = pk2(s[6 * 33], s[7 * 33]);
        *(GAS v4u*)(WT + (size_t)(drow0 + n) * ldt + koff + k0 + 8 * c) = o; }
    LDS_WAIT(); asm volatile("" ::: "memory");
}
__device__ __forceinline__ int glu_row(int n0) { return 256 * (n0 >> 7) + (n0 & 127); }
__device__ __forceinline__ void p0_weight(const float* W, int Ks, int N, bf16* WT, int ldt, int koff, int mode, int item, LAS float* scr, int lane) {
    const int nblk = N / 32, kb = item / nblk, nb = item - kb * nblk, n0 = 32 * nb; int drow0 = n0;
    if (mode == 1) { if (n0 >= 512 && n0 < 1536) { const int r = n0 - 512, tq = r >> 8, mp = (r >> 6) & 3, hf = (r >> 5) & 1; drow0 = 512 + 256 * tq + 128 * hf + 32 * mp; } }
    else if (mode == 2) { drow0 = (n0 < 512) ? glu_row(n0) : glu_row(n0 - 512) + 128; }
    else if (mode == 3) drow0 = glu_row(n0);
    else if (mode == 4) drow0 = glu_row(n0) + 128;
    p0_transpose_item(W, N, WT, ldt, koff, 64 * kb, n0, drow0, scr, lane);
}
__device__ __forceinline__ void p0_build_ssm(Frame& F, int g) {
    const float* lam_re = F.a->in[3]; const float* lam_im = F.a->in[4]; const float* log_step = F.a->in[5];
    const float* b_re = F.a->in[6]; const float* b_im = F.a->in[7]; const float* c_re = F.a->in[8]; const float* c_im = F.a->in[9]; const float* dsk = F.a->in[10];
    LAS float* L = (LAS float*)F.lds;
    LAS float* PWr = L;            LAS float* PWi = L + 17 * 64;
    LAS float* BBr = L + 2176;     LAS float* BBi = L + 2176 + 1024;
    LAS float* Cr = L + 4224;      LAS float* Ci = L + 4224 + 1024;
    LAS float* KT = L + 6272;
    const int tid = ltid(), p = tid & 63, part = tid >> 6;
    {
        const double lr = (double)lam_re[g * 64 + p], li = (double)lam_im[g * 64 + p], dt = (double)__expf(log_step[g]);
        for (int tau = part; tau < 17; tau += 8) { double er, ei; cexpd(lr * dt * tau, li * dt * tau, er, ei); PWr[tau * 64 + p] = (float)er; PWi[tau * 64 + p] = (float)ei;
            if (tau == 16) { float* A16 = (float*)(F.ws + WS_A16); A16[(g * 64 + p) * 2] = (float)er; A16[(g * 64 + p) * 2 + 1] = (float)ei; } }
        double ar, ai; cexpd(lr * dt, li * dt, ar, ai);
        const double nr = ar - 1.0, ni = ai, den = lr * lr + li * li, fr = (nr * lr + ni * li) / den, fi = (ni * lr - nr * li) / den;
#pragma unroll
        for (int hh = 0; hh < 2; ++hh) { const int hi = part * 2 + hh; const double br = (double)b_re[(g * 64 + p) * 16 + hi], bi = (double)b_im[(g * 64 + p) * 16 + hi];
            BBr[p * 16 + hi] = (float)(fr * br - fi * bi); BBi[p * 16 + hi] = (float)(fr * bi + fi * br); }
        Cr[tid] = c_re[g * 1024 + tid]; Cr[tid + 512] = c_re[g * 1024 + tid + 512]; Ci[tid] = c_im[g * 1024 + tid]; Ci[tid + 512] = c_im[g * 1024 + tid + 512];
    }
    __syncthreads();
    for (int j = 0; j < 8; ++j) { const int o = tid + 512 * j, tau = o >> 8, ho = (o >> 4) & 15, hi = o & 15; float s = 0.f;
        for (int q = 0; q < 64; ++q) { const float cr = Cr[ho * 64 + q], ci = Ci[ho * 64 + q], pr = PWr[tau * 64 + q], pi = PWi[tau * 64 + q];
            const float xr = cr * pr - ci * pi, xi = cr * pi + ci * pr; s += xr * BBr[q * 16 + hi] - xi * BBi[q * 16 + hi]; }
        if (tau == 0 && ho == hi) s += dsk[g * 16 + ho];
        KT[o] = s; }
    __syncthreads();
    bf16* TP = (bf16*)(F.ws + WS_TP) + (size_t)g * 256 * 384; bf16* BS = (bf16*)(F.ws + WS_BS) + (size_t)g * 256 * 256;
    for (int ch = tid; ch < 256 * 48; ch += 512) { const int n = ch / 48, kc = ch - n * 48, k0 = 8 * kc, tt = n >> 4, ho = n & 15; float v[8];
        if (k0 < 256) { const int ss = k0 >> 4, hi0 = k0 & 15;
#pragma unroll
            for (int j = 0; j < 8; ++j) v[j] = (tt >= ss) ? KT[((tt - ss) * 16 + ho) * 16 + hi0 + j] : 0.f;
        } else { const bool im = k0 >= 320; const int p0 = k0 - (im ? 320 : 256);
#pragma unroll
            for (int j = 0; j < 8; ++j) { const float cr = Cr[ho * 64 + p0 + j], ci = Ci[ho * 64 + p0 + j], pr = PWr[(tt + 1) * 64 + p0 + j], pi = PWi[(tt + 1) * 64 + p0 + j];
                v[j] = im ? -(cr * pi + ci * pr) : (cr * pr - ci * pi); } }
        v4u o; o.x = pk2(v[0], v[1]); o.y = pk2(v[2], v[3]); o.z = pk2(v[4], v[5]); o.w = pk2(v[6], v[7]);
        *(GAS v4u*)(TP + (size_t)n * 384 + k0) = o; }
    for (int ch = tid; ch < 256 * 32; ch += 512) { const int n = ch >> 5, kc = ch & 31, k0 = 8 * kc, ss = k0 >> 4, hi0 = k0 & 15; float v[8];
        if (n < 128) { const int q = n & 63; const bool im = n >= 64; const float pr = PWr[(15 - ss) * 64 + q], pi = PWi[(15 - ss) * 64 + q];
#pragma unroll
            for (int j = 0; j < 8; ++j) { const float br = BBr[q * 16 + hi0 + j], bi = BBi[q * 16 + hi0 + j]; v[j] = im ? (pr * bi + pi * br) : (pr * br - pi * bi); }
        } else {
#pragma unroll
            for (int j = 0; j < 8; ++j) v[j] = 0.f; }
        v4u o; o.x = pk2(v[0], v[1]); o.y = pk2(v[2], v[3]); o.z = pk2(v[4], v[5]); o.w = pk2(v[6], v[7]);
        *(GAS v4u*)(BS + (size_t)n * 256 + k0) = o; }
    __syncthreads();
}
__device__ __forceinline__ void p0_prologue(Frame& F) {
    const int tid = ltid(), lane = tid & 63;
    for (int g = blockIdx.x; g < 32; g += F.G) p0_build_ssm(F, g);
    LAS float* scr = (LAS float*)(F.lds + F.wave * 16384);
    const int gw = F.vcu * NWAVES + F.wave, NGW = F.G * NWAVES;
    constexpr int I_IN = 16 * 128, I_GLU = 8 * 32, I_PS = 8 * 32, I_PA = 8 * 32, I_OUT = 16 * 32, I_G = 16 * 88, I_U = 16 * 88, I_D = 44 * 32;
    constexpr int NITEMS = I_IN + I_GLU + I_PS + I_PA + I_OUT + I_G + I_U + I_D;
    const float* const* in = F.a->in; unsigned char* ws = F.ws;
    for (int it = gw; it < NITEMS; it += NGW) {
        int r = it;
        if (r < I_IN) { p0_weight(in[1], 1024, 4096, (bf16*)(ws + WS_WIN), 1024, 0, 1, r, scr, lane); continue; } r -= I_IN;
        if (r < I_GLU) { p0_weight(in[11], 512, 1024, (bf16*)(ws + WS_WGLU), 512, 0, 2, r, scr, lane); continue; } r -= I_GLU;
        if (r < I_PS) { p0_weight(in[17], 512, 1024, (bf16*)(ws + WS_WP), 1024, 0, 0, r, scr, lane); continue; } r -= I_PS;
        if (r < I_PA) { p0_weight(in[18], 512, 1024, (bf16*)(ws + WS_WP), 1024, 512, 0, r, scr, lane); continue; } r -= I_PA;
        if (r < I_OUT) { p0_weight(in[19], 1024, 1024, (bf16*)(ws + WS_WOUT), 1024, 0, 0, r, scr, lane); continue; } r -= I_OUT;
        if (r < I_G) { p0_weight(in[22], 1024, 2816, (bf16*)(ws + WS_WGU), 1024, 0, 3, r, scr, lane); continue; } r -= I_G;
        if (r < I_U) { p0_weight(in[23], 1024, 2816, (bf16*)(ws + WS_WGU), 1024, 0, 4, r, scr, lane); continue; } r -= I_U;
        p0_weight(in[24], 2816, 1024, (bf16*)(ws + WS_WD), 2816, 0, 0, r, scr, lane);
    }
    { float* rc = (float*)(ws + WS_ROPE); float* rs = rc + 4096 * 32;
      for (int i = blockIdx.x * 512 + tid; i < 4096 * 32; i += F.G * 512) { const int pos = i >> 5, dd = i & 31; double fr_, fi_, er, ei; cexpd(-0.28782313662425574 * (double)dd, 0.0, fr_, fi_); cexpd(0.0, (double)pos * fr_, er, ei); rc[i] = (float)er; rs[i] = (float)ei; } }
    { const float* x = in[0]; bf16* XB = (bf16*)(ws + WS_XB);
      for (int m = gw; m < M; m += NGW) { const GAS f32x4* xr = (const GAS f32x4*)(x + (size_t)m * 1024) + lane; GAS unsigned long long* o8 = (GAS unsigned long long*)(XB + (size_t)m * 1024) + lane;
#pragma unroll
          for (int j = 0; j < 4; ++j) { const f32x4 v = xr[64 * j]; o8[64 * j] = (unsigned long long)pk2(v.x, v.y) | ((unsigned long long)pk2(v.z, v.w) << 32); } } }
}
__device__ __forceinline__ void ssm_scan(Frame& F) {
    LAS float* TW = (LAS float*)F.lds;
    const float* A16 = (const float*)(F.ws + WS_A16); const float* I = (const float*)(F.ws + WS_I); bf16* AP = (bf16*)(F.ws + WS_AP);
    for (int bg = blockIdx.x; bg < 256; bg += F.G) {
        const int g = bg >> 3, b = bg & 7, p = ltid() & 63, w = F.wave;
        const float ar = A16[(g * 64 + p) * 2], ai = A16[(g * 64 + p) * 2 + 1];
        const float* Ip = I + (size_t)(g * 2048 + b * 256 + 32 * w) * 128 + p;
        float xr[32], xi[32];
#pragma unroll
        for (int j = 0; j < 32; ++j) { xr[j] = Ip[j * 128]; xi[j] = Ip[j * 128 + 64]; }
        float sr = 0.f, si = 0.f;
#pragma unroll
        for (int j = 0; j < 32; ++j) { const float nr = ar * sr - ai * si + xr[j], ni = ar * si + ai * sr + xi[j]; sr = nr; si = ni; xr[j] = sr; xi[j] = si; }
        TW[(w * 64 + p) * 2] = sr; TW[(w * 64 + p) * 2 + 1] = si;
        __syncthreads();
        float qr = ar, qi = ai;
#pragma unroll
        for (int k = 0; k < 5; ++k) { const float t = qr * qr - qi * qi; qi = 2.f * qr * qi; qr = t; }
        float cr = 0.f, ci = 0.f;
        for (int w2 = 0; w2 < w; ++w2) { const float tr = TW[(w2 * 64 + p) * 2], ti = TW[(w2 * 64 + p) * 2 + 1]; const float nr = qr * cr - qi * ci + tr, ni = qr * ci + qi * cr + ti; cr = nr; ci = ni; }
        bf16* dst = AP + (size_t)(g * 2048 + b * 256 + 32 * w + 1) * 384 + 256 + p;
#pragma unroll
        for (int j = 0; j < 32; ++j) { const float t = ar * cr - ai * ci; ci = ar * ci + ai * cr; cr = t;
            if (32 * w + j + 1 < 256) { dst[(size_t)j * 384] = (bf16)f2bf(xr[j] + cr); dst[(size_t)j * 384 + 64] = (bf16)f2bf(xi[j] + ci); } }
        if (w == 0) { bf16* d0 = AP + (size_t)(g * 2048 + b * 256) * 384 + 256 + p; d0[0] = 0; d0[64] = 0; }
        __syncthreads();
    }
}
__device__ __forceinline__ void attn_combine(Frame& F) {
    const int lane = ltid() & 63;
    const float* const* in = F.a->in;
    const float d1 = wave_sum(in[12][lane] * in[13][lane]), d2 = wave_sum(in[14][lane] * in[15][lane]);
    const float lam = __expf(d1) - __expf(d2) + LAMBDA_INIT;
    const int gw = F.vcu * NWAVES + F.wave, NGW = F.G * NWAVES, h = lane >> 4, e0 = (lane & 15) * 8;
    const bf16* O = (const bf16*)(F.ws + WS_O); bf16* CAT = (bf16*)(F.ws + WS_CAT);
    f32x4 ga = *(const f32x4*)(in[16] + e0), gb = *(const f32x4*)(in[16] + e0 + 4);
    ga = ga * (1.0f - LAMBDA_INIT); gb = gb * (1.0f - LAMBDA_INIT);
    for (int m = gw; m < M; m += NGW) {
        const v4u w1 = *(const GAS v4u*)(O + (size_t)m * 1024 + h * 256 + e0), w2 = *(const GAS v4u*)(O + (size_t)m * 1024 + h * 256 + 128 + e0);
        f32x4 a0, a1, b0, b1; pg8::unpack8(w1, a0, a1); pg8::unpack8(w2, b0, b1);
        const f32x4 o0 = a0 - b0 * lam, o1 = a1 - b1 * lam;
        float ss = (o0[0] * o0[0] + o0[1] * o0[1]) + (o0[2] * o0[2] + o0[3] * o0[3]) + (o1[0] * o1[0] + o1[1] * o1[1]) + (o1[2] * o1[2] + o1[3] * o1[3]);
        ss += __shfl_xor(ss, 1); ss += __shfl_xor(ss, 2); ss += __shfl_xor(ss, 4); ss += __shfl_xor(ss, 8);
        const float r = 1.0f / sqrtf(ss * (1.0f / 128.0f) + RMS_EPS);
        *(GAS v4u*)(CAT + (size_t)m * 1024 + 512 + h * 128 + e0) = pg8::pack8(o0 * r * ga, o1 * r * gb);
    }
}
__device__ __forceinline__ void ln_rows(Frame& F, float* X, const float* gam, const float* bet, bf16* XBo) {
    const int lane = ltid() & 63;
    const int gw = F.vcu * NWAVES + F.wave, NGW = F.G * NWAVES;
    f32x4 gv[4], bv[4];
#pragma unroll
    for (int j = 0; j < 4; ++j) { gv[j] = *(const f32x4*)(gam + 4 * lane + 256 * j); bv[j] = *(const f32x4*)(bet + 4 * lane + 256 * j); }
    for (int m = gw; m < M; m += NGW) {
        GAS f32x4* xr = (GAS f32x4*)(X + (size_t)m * 1024) + lane;
        f32x4 v[4]; float s = 0.f;
#pragma unroll
        for (int j = 0; j < 4; ++j) { v[j] = xr[64 * j]; s += (v[j].x + v[j].y) + (v[j].z + v[j].w); }
        const float mean = wave_sum(s) * (1.f / 1024.f); float s2 = 0.f;
#pragma unroll
        for (int j = 0; j < 4; ++j) { v[j] = v[j] - mean; s2 += (v[j].x * v[j].x + v[j].y * v[j].y) + (v[j].z * v[j].z + v[j].w * v[j].w); }
        const float rstd = 1.f / sqrtf(wave_sum(s2) * (1.f / 1024.f) + LN_EPS);
#pragma unroll
        for (int j = 0; j < 4; ++j) { v[j] = v[j] * rstd * gv[j] + bv[j]; xr[64 * j] = v[j]; }
        if (XBo) { GAS unsigned long long* o8 = (GAS unsigned long long*)(XBo + (size_t)m * 1024) + lane;
#pragma unroll
            for (int j = 0; j < 4; ++j) o8[64 * j] = (unsigned long long)pk2(v[j].x, v[j].y) | ((unsigned long long)pk2(v[j].z, v[j].w) << 32); }
    }
}
__device__ __forceinline__ void attn_all(Frame& F, char* lds) {
    const attn_body::bf16* Q = (const attn_body::bf16*)(F.ws + WS_Q); const attn_body::bf16* K = (const attn_body::bf16*)(F.ws + WS_K);
    const attn_body::bf16* V = (const attn_body::bf16*)(F.ws + WS_V); attn_body::bf16* O = (attn_body::bf16*)(F.ws + WS_O);
    for (int j = F.vcu; j < 1024; j += F.G) {
        const int bh = j >> 3, jj = j & 7, b = bh >> 4, hh = bh & 15, head = hh >> 2, mp = (hh >> 1) & 1, vh = hh & 1;
        const int qcol = (head * 2 + mp) * 64, vcol = head * 128 + vh * 64, ocol = ((head * 2 + mp) * 2 + vh) * 64;
        attn_body::attn_unit<8>(b, qcol, vcol, ocol, 15 - jj, Q, K, V, O, lds);
        attn_body::attn_unit<8>(b, qcol, vcol, ocol, jj, Q, K, V, O, lds);
    }
}

constexpr int N_PHASES = 13;
__global__ void __launch_bounds__(NWAVES * 64, 2) fwd_kernel(Args args) {
    extern __shared__ __attribute__((aligned(16))) unsigned char lds[];
    Frame F;
    F.lds = (LAS unsigned char*)lds; F.wave = __builtin_amdgcn_readfirstlane((int)threadIdx.x >> 6);
    F.G = gridDim.x; { const int bx = blockIdx.x; F.vcu = (F.G % 8 == 0) ? (bx % 8) * (F.G / 8) + bx / 8 : bx; }
    F.a = &args; F.ws = args.ws;
    unsigned char* ws = args.ws; const float* const* in = args.in;
    const int lo = args.ph_lo, hi = args.ph_hi;
    volatile LAS unsigned* MISC = (volatile LAS unsigned*)(F.lds + RING_BYTES + 320);
    if (threadIdx.x < 32) MISC[threadIdx.x] = 0u;
    __syncthreads();
    XcdBarrier bar; bar.bar = (unsigned*)(ws + WS_CTL); bar.x = 0; bar.st = nullptr;
    if (hi - lo > 1) {
        cg::this_grid().sync();
        bar = xcd_barrier_post((unsigned*)(ws + WS_CTL), MISC + 8);
    }
#ifndef PHMASK
#define PHMASK 0x1fff
#endif
#define IN(k) (((PHMASK >> (k)) & 1) && lo <= (k) && (k) < hi)
#define SEAM(k) do { if (IN(k) && IN((k) + 1)) { xcd_barrier(bar); } } while (0)
    typedef pg8::bf16_t pb;
    const int cblk = (int)blockIdx.x;

    if (IN(0)) { p0_prologue(F); }
    SEAM(0);
    if (IN(1)) {
        pg8::Gemm g{1024, 1024, 1024};
        pg8::TileOrder S{M / 256, 16, (M / 256) * 16, F.G, cblk, 1, 0, (const char*)(ws + WS_XB), (const char*)(ws + WS_WIN), (size_t)256 * 1024 * 2, (size_t)256 * 1024 * 2, 0, 0};
        pg8::EpiInProj E{(pb*)(ws + WS_AP), (pb*)(ws + WS_Q), (pb*)(ws + WS_K), (pb*)(ws + WS_V), (pb*)(ws + WS_G0), (pb*)(ws + WS_G1), (const float*)(ws + WS_ROPE), (const float*)(ws + WS_ROPE) + 4096 * 32, in[2], QSCALE};
        pg8::gemm_phase<pg8::EpiInProj, pg8::TileOrder, true>(F.lds, g, S, E);
    }
    SEAM(1);
    if (IN(2)) {
        pg8::Gemm g{384, 256, 256};
        pg8::TileOrder S{256, 1, 256, F.G, cblk, 1, 1, (const char*)(ws + WS_AP), (const char*)(ws + WS_BS), (size_t)256 * 384 * 2, (size_t)256 * 256 * 2, 0, 0};
        pg8::EpiSsmInc E{(float*)(ws + WS_I)};
        pg8::gemm_phase<pg8::EpiSsmInc, pg8::TileOrder, true>(F.lds, g, S, E);
    }
    SEAM(2);
    if (IN(3)) { ssm_scan(F); }
    SEAM(3);
    if (IN(4)) {
        pg8::Gemm g{384, 384, 384};
        pg8::TileOrder S{256, 1, 256, F.G, cblk, 1, 1, (const char*)(ws + WS_AP), (const char*)(ws + WS_TP), (size_t)256 * 384 * 2, (size_t)256 * 384 * 2, 0, 0};
        pg8::EpiSsmOut E{(pb*)(ws + WS_YG)};
        pg8::gemm_phase<pg8::EpiSsmOut, pg8::TileOrder, true>(F.lds, g, S, E);
    }
    SEAM(4);
    if (IN(5)) {
        {
            pg8::Gemm g{512, 512, 512};
            pg8::TileOrder S{M / 256, 4, (M / 256) * 4, F.G, cblk, 1, 0, (const char*)(ws + WS_YG), (const char*)(ws + WS_WGLU), (size_t)256 * 512 * 2, (size_t)256 * 512 * 2, 0, 0};
            pg8::EpiGlu<false> E{(pb*)(ws + WS_CAT), 1024};
            pg8::gemm_phase<pg8::EpiGlu<false>, pg8::TileOrder, true>(F.lds, g, S, E);
        }
        attn_all(F, (char*)lds);
    }
    SEAM(5);
    if (IN(6)) { attn_combine(F); }
    SEAM(6);
    if (IN(7)) {
        pg8::Gemm g{1024, 1024, 512};
        pg8::TileOrder S{M / 256, 4, (M / 256) * 4, F.G, cblk, 2, 0, (const char*)(ws + WS_CAT), (const char*)(ws + WS_WP), (size_t)256 * 1024 * 2, (size_t)256 * 1024 * 2, (size_t)512 * 2, (size_t)512 * 2};
        pg8::EpiMerge E{(const pb*)(ws + WS_G0), (const pb*)(ws + WS_G1), (pb*)(ws + WS_MRG)};
        pg8::gemm_phase<pg8::EpiMerge, pg8::TileOrder, true>(F.lds, g, S, E);
    }
    SEAM(7);
    if (IN(8)) {
        pg8::Gemm g{1024, 1024, 1024};
        pg8::TileOrder S{M / 256, 4, (M / 256) * 4, F.G, cblk, 1, 0, (const char*)(ws + WS_MRG), (const char*)(ws + WS_WOUT), (size_t)256 * 1024 * 2, (size_t)256 * 1024 * 2, 0, 0};
        pg8::EpiRes E{in[0], (float*)(ws + WS_X1), ALPHA};
        pg8::gemm_phase<pg8::EpiRes, pg8::TileOrder, true>(F.lds, g, S, E);
    }
    SEAM(8);
    if (IN(9)) { ln_rows(F, (float*)(ws + WS_X1), in[20], in[21], (bf16*)(ws + WS_X1B)); }
    SEAM(9);
    if (IN(10)) {
        pg8::Gemm g{1024, 1024, 1024};
        pg8::TileOrder S{M / 256, 22, (M / 256) * 22, F.G, cblk, 1, 0, (const char*)(ws + WS_X1B), (const char*)(ws + WS_WGU), (size_t)256 * 1024 * 2, (size_t)256 * 1024 * 2, 0, 0};
        pg8::EpiGlu<true> E{(pb*)(ws + WS_ACT), DFF};
        pg8::gemm_phase<pg8::EpiGlu<true>, pg8::TileOrder, true>(F.lds, g, S, E);
    }
    SEAM(10);
    if (IN(11)) {
        pg8::Gemm g{DFF, DFF, DFF};
        pg8::TileOrder S{M / 256, 4, (M / 256) * 4, F.G, cblk, 1, 0, (const char*)(ws + WS_ACT), (const char*)(ws + WS_WD), (size_t)256 * DFF * 2, (size_t)256 * DFF * 2, 0, 0};
        pg8::EpiRes E{(const float*)(ws + WS_X1), args.out, ALPHA};
        pg8::gemm_phase<pg8::EpiRes, pg8::TileOrder, true>(F.lds, g, S, E);
    }
    SEAM(11);
    if (IN(12)) { ln_rows(F, args.out, in[25], in[26], nullptr); }
#undef IN
#undef SEAM
}


#ifdef DBG_CK
__global__ void ck_kernel(const unsigned* p, size_t nwords, unsigned* out) {
    unsigned s = 0; for (size_t i = (size_t)blockIdx.x * blockDim.x + threadIdx.x; i < nwords; i += (size_t)gridDim.x * blockDim.x) s += p[i] * ((unsigned)i * 2654435761u | 1u);
#pragma unroll
    for (int o = 32; o >= 1; o >>= 1) s += __shfl_xor(s, o);
    if ((threadIdx.x & 63) == 0) atomicAdd(out, s);
}
__global__ void fin_kernel(const unsigned* cs, float* out, int n) {
    const int i = blockIdx.x * blockDim.x + threadIdx.x; if (i < n) out[i] = 0.f;
    if (i == 0) { int k; for (k = 0; k < 13; ++k) if (cs[k] != cs[16 + k]) break; int mask = 0; for (int r = 0; r < 5; ++r) if (cs[32 + r] != cs[40 + r]) mask |= 1 << r; out[0] = (k < 13) ? 1000.f * (float)(k + 1) : 0.f; out[1] = 100.f * (float)mask; (void)k; if (k == 1) out[0] = 100.f * (float)mask + 50000.f; }
}
#endif
extern "C" void kernel_launch(void* const* d_in, const int* in_sizes, int n_in, void* d_out, int out_size, void* d_ws, size_t ws_size, hipStream_t stream) {
    static int grid = 0;
    if (grid == 0) {
        if (n_in != 27 || in_sizes[0] != M * DMOD || out_size != M * DMOD || ws_size < WS_END) { fprintf(stderr, "kernel_launch: unexpected shapes (n_in %d, in0 %d, out %d, ws %zu)\n", n_in, n_in > 0 ? in_sizes[0] : -1, out_size, ws_size); grid = -1; return; }
        int dev = 0, cus = 0, per_cu = 0;
        if (hipGetDevice(&dev) != hipSuccess || hipDeviceGetAttribute(&cus, hipDeviceAttributeMultiprocessorCount, dev) != hipSuccess) { grid = -1; return; }
        if (hipFuncSetAttribute((const void*)fwd_kernel, hipFuncAttributeMaxDynamicSharedMemorySize, LDS_BYTES) != hipSuccess) { fprintf(stderr, "kernel_launch: hipFuncSetAttribute failed\n"); grid = -1; return; }
        if (hipOccupancyMaxActiveBlocksPerMultiprocessor(&per_cu, (const void*)fwd_kernel, NWAVES * 64, LDS_BYTES) != hipSuccess || per_cu < 1) { fprintf(stderr, "kernel_launch: occupancy query says %d\n", per_cu); per_cu = 1; }
        (void)hipGetLastError();
        grid = cus;
    }
    if (grid < 0) return;
    if (hipMemsetAsync((char*)d_ws + WS_CTL, 0, CTL_BYTES, stream) != hipSuccess) { fprintf(stderr, "kernel_launch: memset failed\n"); return; }
#ifdef DBG_POISON
    (void)hipMemsetAsync((char*)d_ws + CTL_BYTES, 0xAA, WS_END - CTL_BYTES, stream); (void)hipMemsetAsync(d_out, 0xAA, (size_t)out_size * 4, stream);
#endif
    Args a{};
    for (int i = 0; i < 27; ++i) a.in[i] = (const float*)d_in[i];
    a.out = (float*)d_out; a.ws = (unsigned char*)d_ws;
#if MK_N_LAUNCHES == 1
    a.ph_lo = 0; a.ph_hi = N_PHASES;
    void* kargs[] = {&a};
    hipError_t e = hipLaunchCooperativeKernel((const void*)fwd_kernel, dim3(grid), dim3(NWAVES * 64), kargs, LDS_BYTES, stream);
    if (e != hipSuccess) fprintf(stderr, "kernel_launch: cooperative launch failed: %s (grid %d)\n", hipGetErrorString(e), grid);
#else
#ifdef DBG_CK
    unsigned* cs = (unsigned*)((char*)d_ws + 14400);
    static const size_t roff[13] = {1, 112, 384, 336, 416, 448, 48, 240, 304, 304, 48, 0, 0}, rsz[13] = {42, 224, 32, 48, 32, 64, 64, 64, 128, 192, 176, 0, 0};
    for (int pass = 0; pass < 2; ++pass)
    for (int ph = 0; ph < N_PHASES; ++ph) {
        a.ph_lo = ph; a.ph_hi = ph + 1;
        hipLaunchKernelGGL(fwd_kernel, dim3(grid), dim3(NWAVES * 64), LDS_BYTES, stream, a);
        if (ph == 1) { static const size_t o5[5] = {112, 176, 240, 272, 304}, s5[5] = {64, 64, 32, 32, 32};
            for (int r5 = 0; r5 < 5; ++r5) hipLaunchKernelGGL(ck_kernel, dim3(1024), dim3(256), 0, stream, (const unsigned*)((char*)d_ws + o5[r5] * MiB), s5[r5] * MiB / 4, cs + 32 + pass * 8 + r5); }
        if (ph >= 11) hipLaunchKernelGGL(ck_kernel, dim3(1024), dim3(256), 0, stream, (const unsigned*)d_out, (size_t)out_size, cs + pass * 16 + ph);
        else { hipLaunchKernelGGL(ck_kernel, dim3(1024), dim3(256), 0, stream, (const unsigned*)((char*)d_ws + roff[ph] * MiB), rsz[ph] * MiB / 4, cs + pass * 16 + ph);
               if (ph == 0) hipLaunchKernelGGL(ck_kernel, dim3(1024), dim3(256), 0, stream, (const unsigned*)((char*)d_ws + 48 * MiB), 64 * MiB / 4, cs + pass * 16 + ph); }
    }
    hipLaunchKernelGGL(fin_kernel, dim3((out_size + 255) / 256), dim3(256), 0, stream, (const unsigned*)cs, (float*)d_out, out_size);
#else
    for (int ph = 0; ph < N_PHASES; ++ph) {
        a.ph_lo = ph; a.ph_hi = ph + 1;
        hipLaunchKernelGGL(fwd_kernel, dim3(grid), dim3(NWAVES * 64), LDS_BYTES, stream, a);
    }
#endif
#endif
}
```
